# Optimizing an MI355X kernel written in HIP

```python
import jax, jax.numpy as jnp
from jax import lax
import numpy as np

D_MODEL = 2048
BATCH = 2
SEQ = 8192
DEPTH = 2

HEAD_DIM = 128
N_HEADS = 16
N_KV = 4
GQA_REP = N_HEADS // N_KV
CMP_BLOCK = 32
CMP_STRIDE = 16
CMP_HIDDEN = 128
SLC_BLOCK = 64
SLC_TOPK = 16
WINDOW = 512
Q_BLOCK = 128
SLC_Q_BLOCK = 16
N_GROUPS = 4
EXPERTS_PER_GROUP = 8
N_EXPERTS = N_GROUPS * EXPERTS_PER_GROUP
TOP_K_IN_GROUP = 2
D_EXPERT = 512
N_MIXERS = 2
N_LAYERS_A = (DEPTH + 1) // 2
N_LAYERS_B = DEPTH // 2
Q_DIM = N_HEADS * HEAD_DIM
KV_DIM = N_KV * HEAD_DIM
NSA_IN = Q_DIM + 6 * KV_DIM + 3 * N_HEADS
SB_IN = 3 * Q_DIM
EPS = 1e-6
NEG = -1e30

kernel_name = "hybrid_nsa_stickbreak_hmoe"


def rms_norm(x, g):
    xf = x.astype(jnp.float32)
    y = xf * lax.rsqrt(jnp.mean(xf * xf, axis=-1, keepdims=True) + EPS)
    return (y * g.astype(jnp.float32)).astype(x.dtype)


def masked_softmax(s, mask):
    p = jax.nn.softmax(jnp.where(mask, s, NEG), axis=-1)
    return jnp.where(mask, p, 0.0)


def alibi_slopes():
    m = jnp.exp2(-8.0 * jnp.arange(1, N_HEADS + 1, dtype=jnp.float32) / N_HEADS)
    return m.reshape(N_KV, GQA_REP)


def cmp_to_slc_matrix(n_cmp, n_slc):
    cs = jnp.arange(n_cmp) * CMP_STRIDE
    ss = jnp.arange(n_slc) * SLC_BLOCK
    lo = jnp.maximum(cs[:, None], ss[None, :])
    hi = jnp.minimum(cs[:, None] + CMP_BLOCK, ss[None, :] + SLC_BLOCK)
    return jnp.maximum(hi - lo, 0).astype(jnp.float32) / CMP_BLOCK


def nsa_mixer(h, w_in, qk_gain, cmp_pe, cmp_w1, cmp_w2, w_out):
    B, T, _ = h.shape
    n_cmp = (T - CMP_BLOCK) // CMP_STRIDE + 1
    n_slc = T // SLC_BLOCK
    top_k = min(SLC_TOPK, n_slc)
    n_qb = T // Q_BLOCK
    n_sb = T // SLC_Q_BLOCK
    scale = HEAD_DIM ** -0.5
    proj = h @ w_in
    q, kv_c, k_s, v_s, k_w, v_w, gates = jnp.split(
        proj, [Q_DIM, Q_DIM + 2 * KV_DIM, Q_DIM + 3 * KV_DIM, Q_DIM + 4 * KV_DIM,
               Q_DIM + 5 * KV_DIM, Q_DIM + 6 * KV_DIM], axis=-1)
    q = rms_norm(q.reshape(B, T, N_KV, GQA_REP, HEAD_DIM), qk_gain[0]).transpose(0, 2, 3, 1, 4)
    kv_heads = lambda a: a.reshape(B, T, N_KV, HEAD_DIM).transpose(0, 2, 1, 3)
    k_s = rms_norm(kv_heads(k_s), qk_gain[2])
    v_s = kv_heads(v_s)
    k_w = rms_norm(kv_heads(k_w), qk_gain[3])
    v_w = kv_heads(v_w)

    kv_c = kv_c.reshape(B, T, 2, N_KV, HEAD_DIM)
    tok = jnp.arange(n_cmp)[:, None] * CMP_STRIDE + jnp.arange(CMP_BLOCK)[None, :]
    blocks = kv_c[:, tok] + cmp_pe.transpose(1, 0, 2)[None, None, :, :, None, :]
    hid = jax.nn.gelu(jnp.einsum('bnlkgd,kldf->bnkgf', blocks, cmp_w1))
    cmp = jnp.einsum('bnkgf,kfd->kbgnd', hid, cmp_w2)
    k_c = rms_norm(cmp[0], qk_gain[1])
    v_c = cmp[1]
    cmp_end = jnp.arange(n_cmp) * CMP_STRIDE + CMP_BLOCK - 1

    slopes = alibi_slopes()[None, :, :, None, None]
    m_sel = cmp_to_slc_matrix(n_cmp, n_slc)
    blk_ids = jnp.arange(n_slc)
    pad = ((0, 0), (0, 0), (WINDOW, 0), (0, 0))
    k_w_pad = jnp.pad(k_w, pad)
    v_w_pad = jnp.pad(v_w, pad)
    q_blocks = jnp.moveaxis(q.reshape(B, N_KV, GQA_REP, n_qb, Q_BLOCK, HEAD_DIM), 3, 0)

    def cmp_win_block(args):
        qb, c = args
        t = c * Q_BLOCK + jnp.arange(Q_BLOCK)
        s_c = jnp.einsum('bgrqd,bgnd->bgrqn', qb, k_c).astype(jnp.float32) * scale
        dist_c = (t[:, None] - cmp_end[None, :]).astype(jnp.float32)
        p_c = masked_softmax(s_c - slopes * dist_c, cmp_end[None, :] <= t[:, None])
        o_c = jnp.einsum('bgrqn,bgnd->bgrqd', p_c.astype(v_c.dtype), v_c)
        imp = jnp.einsum('bgqn,nj->bgqj', p_c.sum(axis=2), m_sel)
        causal = blk_ids[None, :] * SLC_BLOCK <= t[:, None]
        forced = (blk_ids[None, :] == 0) | (blk_ids[None, :] == (t // SLC_BLOCK)[:, None])
        score = jnp.where(forced, -NEG, jnp.where(causal, imp, NEG))
        vals, idx = lax.top_k(score, top_k)
        valid = vals > 0.5 * NEG
        kw = lax.dynamic_slice_in_dim(k_w_pad, c * Q_BLOCK, Q_BLOCK + WINDOW, axis=2)
        vw = lax.dynamic_slice_in_dim(v_w_pad, c * Q_BLOCK, Q_BLOCK + WINDOW, axis=2)
        spos = c * Q_BLOCK - WINDOW + jnp.arange(Q_BLOCK + WINDOW)
        dist_w = t[:, None] - spos[None, :]
        mask_w = (dist_w >= 0) & (dist_w < WINDOW) & (spos[None, :] >= 0)
        s_w = jnp.einsum('bgrqd,bgkd->bgrqk', qb, kw).astype(jnp.float32) * scale - slopes * dist_w.astype(jnp.float32)
        o_w = jnp.einsum('bgrqk,bgkd->bgrqd', masked_softmax(s_w, mask_w).astype(vw.dtype), vw)
        return o_c, o_w, idx, valid

    o_c, o_w, idx, valid = lax.map(cmp_win_block, (q_blocks, jnp.arange(n_qb)))
    unblock = lambda o: jnp.moveaxis(o, 0, 3).reshape(B, N_KV, GQA_REP, T, HEAD_DIM)
    o_c = unblock(o_c)
    o_w = unblock(o_w)
    idx = jnp.moveaxis(idx, 0, 2).reshape(B, N_KV, T, top_k)
    valid = jnp.moveaxis(valid, 0, 2).reshape(B, N_KV, T, top_k)

    k_blk = k_s.reshape(B, N_KV, n_slc, SLC_BLOCK, HEAD_DIM)
    v_blk = v_s.reshape(B, N_KV, n_slc, SLC_BLOCK, HEAD_DIM)
    bi = jnp.arange(B)[:, None, None, None]
    gi = jnp.arange(N_KV)[None, :, None, None]
    q_sb = jnp.moveaxis(q.reshape(B, N_KV, GQA_REP, n_sb, SLC_Q_BLOCK, HEAD_DIM), 3, 0)
    idx_sb = jnp.moveaxis(idx.reshape(B, N_KV, n_sb, SLC_Q_BLOCK, top_k), 2, 0)
    val_sb = jnp.moveaxis(valid.reshape(B, N_KV, n_sb, SLC_Q_BLOCK, top_k), 2, 0)
    n_keys = top_k * SLC_BLOCK

    def slc_block(args):
        qb, ib, vb, c = args
        t = c * SLC_Q_BLOCK + jnp.arange(SLC_Q_BLOCK)
        ks = k_blk[bi, gi, ib].reshape(B, N_KV, SLC_Q_BLOCK, n_keys, HEAD_DIM)
        vs = v_blk[bi, gi, ib].reshape(B, N_KV, SLC_Q_BLOCK, n_keys, HEAD_DIM)
        pos = (ib[..., None] * SLC_BLOCK + jnp.arange(SLC_BLOCK)).reshape(B, N_KV, SLC_Q_BLOCK, n_keys)
        dist = t[None, None, :, None] - pos
        mask = (jnp.repeat(vb, SLC_BLOCK, axis=-1) & (dist >= 0))[:, :, None]
        s = jnp.einsum('bgrqd,bgqkd->bgrqk', qb, ks).astype(jnp.float32) * scale - slopes * dist[:, :, None].astype(jnp.float32)
        p = masked_softmax(s, mask)
        return jnp.einsum('bgrqk,bgqkd->bgrqd', p.astype(vs.dtype), vs)

    o_s = unblock(lax.map(slc_block, (q_sb, idx_sb, val_sb, jnp.arange(n_sb))))

    g = jax.nn.sigmoid(gates.reshape(B, T, 3, N_KV, GQA_REP).astype(jnp.float32)).astype(h.dtype)
    g = g.transpose(2, 0, 3, 4, 1)[..., None]
    o = g[0] * o_c + g[1] * o_s + g[2] * o_w
    return o.transpose(0, 3, 1, 2, 4).reshape(B, T, Q_DIM) @ w_out


def stick_breaking_mixer(h, w_in, w_out):
    B, T, _ = h.shape
    n_qb = T // Q_BLOCK
    scale = HEAD_DIM ** -0.5
    q, k, v = jnp.split(h @ w_in, 3, axis=-1)
    to_heads = lambda a: a.reshape(B, T, N_HEADS, HEAD_DIM).transpose(0, 2, 1, 3)
    q, k, v = to_heads(q), to_heads(k), to_heads(v)
    q_blocks = jnp.moveaxis(q.reshape(B, N_HEADS, n_qb, Q_BLOCK, HEAD_DIM), 2, 0)
    spos = jnp.arange(T)

    def sb_block(args):
        qb, c = args
        t = c * Q_BLOCK + jnp.arange(Q_BLOCK)
        z = jnp.einsum('bhqd,bhkd->bhqk', qb, k).astype(jnp.float32) * scale
        mask = spos[None, :] < t[:, None]
        log_fail = jnp.where(mask, jax.nn.log_sigmoid(-z), 0.0)
        after = lax.cumsum(log_fail, axis=3, reverse=True) - log_fail
        a = jnp.where(mask, jnp.exp(jax.nn.log_sigmoid(z) + after), 0.0)
        return jnp.einsum('bhqk,bhkd->bhqd', a.astype(v.dtype), v)

    o = lax.map(sb_block, (q_blocks, jnp.arange(n_qb)))
    o = jnp.moveaxis(o, 0, 2).reshape(B, N_HEADS, T, HEAD_DIM).transpose(0, 2, 1, 3).reshape(B, T, Q_DIM)
    return o @ w_out


def hier_moe(h, w_group, b_group, w_router, b_router, w_gate, w_up, w_down):
    B, T, D = h.shape
    hf = h.reshape(B * T, D)
    p_group = jax.nn.softmax((hf @ w_group + b_group).astype(jnp.float32), axis=-1)
    pg, gsel = lax.top_k(p_group, 1)
    logits = (hf @ w_router + b_router).astype(jnp.float32).reshape(-1, N_GROUPS, EXPERTS_PER_GROUP)
    in_group = jnp.take_along_axis(logits, gsel[:, :, None], axis=1)[:, 0]
    pe, esel = lax.top_k(jax.nn.softmax(in_group, axis=-1), TOP_K_IN_GROUP)
    weight = pg * pe / jnp.sum(pe, axis=-1, keepdims=True)
    expert_id = gsel * EXPERTS_PER_GROUP + esel
    combine = jnp.sum(jax.nn.one_hot(expert_id, N_EXPERTS, dtype=jnp.float32) * weight[..., None], axis=1)
    combine = combine.astype(hf.dtype)
    out = jnp.zeros_like(hf)
    for e in range(N_EXPERTS):
        y = (jax.nn.silu(hf @ w_gate[e]) * (hf @ w_up[e])) @ w_down[e]
        out = out + combine[:, e:e + 1] * y
    return out.reshape(B, T, D)


def setup_inputs(seed: int = 0) -> dict:
    key = jax.random.key(seed)
    ks = jax.random.split(key, 20)
    nrm = lambda k, shape, s: jax.random.normal(k, shape, jnp.float32) * s
    return {
        "x": nrm(ks[0], (BATCH, SEQ, D_MODEL), 1.0),
        "norm_mix": 1.0 + nrm(ks[1], (DEPTH, D_MODEL), 0.02),
        "norm_ffn": 1.0 + nrm(ks[2], (DEPTH, D_MODEL), 0.02),
        "nsa_w_in": nrm(ks[3], (N_LAYERS_A, D_MODEL, NSA_IN), D_MODEL ** -0.5),
        "nsa_qk_gain": 1.0 + nrm(ks[4], (N_LAYERS_A, 4, HEAD_DIM), 0.02),
        "nsa_cmp_pe": nrm(ks[5], (N_LAYERS_A, 2, CMP_BLOCK, HEAD_DIM), 0.1),
        "nsa_cmp_w1": nrm(ks[6], (N_LAYERS_A, 2, CMP_BLOCK, HEAD_DIM, CMP_HIDDEN), (CMP_BLOCK * HEAD_DIM) ** -0.5),
        "nsa_cmp_w2": nrm(ks[7], (N_LAYERS_A, 2, CMP_HIDDEN, HEAD_DIM), CMP_HIDDEN ** -0.5),
        "nsa_w_out": nrm(ks[8], (N_LAYERS_A, Q_DIM, D_MODEL), Q_DIM ** -0.5),
        "sb_w_in": nrm(ks[9], (N_LAYERS_B, D_MODEL, SB_IN), D_MODEL ** -0.5),
        "sb_w_out": nrm(ks[10], (N_LAYERS_B, Q_DIM, D_MODEL), Q_DIM ** -0.5),
        "moe_w_group": nrm(ks[11], (DEPTH, D_MODEL, N_GROUPS), D_MODEL ** -0.5),
        "moe_b_group": nrm(ks[12], (DEPTH, N_GROUPS), 0.01),
        "moe_w_router": nrm(ks[13], (DEPTH, D_MODEL, N_EXPERTS), D_MODEL ** -0.5),
        "moe_b_router": nrm(ks[14], (DEPTH, N_EXPERTS), 0.01),
        "moe_w_gate": nrm(ks[15], (DEPTH, N_EXPERTS, D_MODEL, D_EXPERT), D_MODEL ** -0.5),
        "moe_w_up": nrm(ks[16], (DEPTH, N_EXPERTS, D_MODEL, D_EXPERT), D_MODEL ** -0.5),
        "moe_w_down": nrm(ks[17], (DEPTH, N_EXPERTS, D_EXPERT, D_MODEL), D_EXPERT ** -0.5),
    }


def reference(x, norm_mix, norm_ffn, nsa_w_in, nsa_qk_gain, nsa_cmp_pe, nsa_cmp_w1, nsa_cmp_w2, nsa_w_out,
              sb_w_in, sb_w_out, moe_w_group, moe_b_group, moe_w_router, moe_b_router,
              moe_w_gate, moe_w_up, moe_w_down):
    for i in range(DEPTH):
        h = rms_norm(x, norm_mix[i])
        j = i // N_MIXERS
        if i % N_MIXERS == 0:
            mix = nsa_mixer(h, nsa_w_in[j], nsa_qk_gain[j], nsa_cmp_pe[j], nsa_cmp_w1[j], nsa_cmp_w2[j], nsa_w_out[j])
        else:
            mix = stick_breaking_mixer(h, sb_w_in[j], sb_w_out[j])
        x = x + mix
        x = x + hier_moe(rms_norm(x, norm_ffn[i]), moe_w_group[i], moe_b_group[i], moe_w_router[i], moe_b_router[i],
                         moe_w_gate[i], moe_w_up[i], moe_w_down[i])
    return x
```

```cpp
#include <hip/hip_runtime.h>
#include <stdint.h>
#include <stdio.h>

#define LAS __attribute__((address_space(3)))
#define DI __device__ __forceinline__
typedef unsigned short bf16_t;
typedef short bf16x8 __attribute__((ext_vector_type(8)));
typedef short s16x4 __attribute__((ext_vector_type(4)));
typedef float f32x4 __attribute__((ext_vector_type(4)));
typedef float f32x2 __attribute__((ext_vector_type(2)));
typedef float f32x16 __attribute__((ext_vector_type(16)));
typedef unsigned u32x4 __attribute__((ext_vector_type(4)));
typedef unsigned u32x2 __attribute__((ext_vector_type(2)));

constexpr int T_ = 8192, B_ = 2, NTOK = B_ * T_, DM = 2048, HD = 128, NH = 16, NKV = 4;
constexpr int LDP0 = 5376;
constexpr int C_Q = 0, C_KC = 2048, C_VC = 2560, C_KS = 3072, C_VS = 3584, C_KW = 4096, C_VW = 4608, C_GT = 5120;
constexpr int LDP1 = 6144;
constexpr int NEXP = 32, DEXP = 512;
constexpr int MAXTILES = 160;
constexpr float LOG2E = 1.4426950408889634f;
constexpr float QSCALE = 0.08838834764831845f;

constexpr size_t WS_BAR   = 0;
constexpr size_t WS_CNT   = 16384;
constexpr size_t WS_ZERO_BYTES = 32768;
constexpr size_t WS_BIAS1 = 32768;
constexpr size_t WS_WIN0  = 1u << 20;
constexpr size_t WS_WOUT0 = WS_WIN0 + (size_t)LDP0 * DM * 2;
constexpr size_t WS_WIN1  = WS_WOUT0 + (size_t)DM * DM * 2;
constexpr size_t WS_WOUT1 = WS_WIN1 + (size_t)LDP1 * DM * 2;
constexpr size_t WS_WR    = WS_WOUT1 + (size_t)DM * DM * 2;
constexpr size_t WS_W1    = WS_WR + (size_t)2 * 256 * DM * 2;
constexpr size_t WS_W2    = WS_W1 + (size_t)2 * 32 * 1024 * DM * 2;
constexpr size_t WS_CW1   = WS_W2 + (size_t)2 * 32 * DM * 512 * 2;
constexpr size_t WS_CW2   = WS_CW1 + (size_t)2 * 128 * 4096 * 2;
constexpr size_t WS_H     = WS_CW2 + (size_t)2 * 128 * 128 * 2;
constexpr size_t WS_PROJ  = WS_H + (size_t)NTOK * DM * 2;
constexpr size_t WS_ATT   = WS_PROJ + (size_t)NTOK * LDP1 * 2;
constexpr size_t WS_XR    = WS_ATT + (size_t)NTOK * DM * 2;
constexpr size_t WS_KCMP  = WS_XR + (size_t)NTOK * DM * 4;
constexpr size_t WS_VCMP  = WS_KCMP + (size_t)2 * 4 * 512 * 128 * 2;
constexpr size_t WS_ROWS  = WS_VCMP + (size_t)2 * 4 * 512 * 128 * 2;
constexpr size_t WS_TOK   = WS_ROWS + (size_t)32 * 16384 * 4;
constexpr size_t WS_END   = WS_TOK + (size_t)NTOK * 32;

constexpr int LDS_STAGE = 131072;
constexpr int LDS_MISC  = 131072;
constexpr int LDS_BYTES = 131072 + 4096;

DI unsigned cvtpk(float lo, float hi) { unsigned r; asm volatile("v_cvt_pk_bf16_f32 %0, %1, %2" : "=v"(r) : "v"(lo), "v"(hi)); return r; }
DI float bflo(unsigned w) { return __uint_as_float(w << 16); }
DI float bfhi(unsigned w) { return __uint_as_float(w & 0xffff0000u); }
DI float wave_sum(float v) { for (int o = 32; o >= 1; o >>= 1) v += __shfl_xor(v, o); return v; }
DI bf16x8 pack8(f32x4 a, f32x4 b) { u32x4 w = {cvtpk(a[0], a[1]), cvtpk(a[2], a[3]), cvtpk(b[0], b[1]), cvtpk(b[2], b[3])}; return __builtin_bit_cast(bf16x8, w); }

#define XB_TMO      128
#define XB_XCNT(j)  (256  + 64 * (j))
#define XB_XSUB(j)  (1280 + 64 * (j))
#define XB_XGEN(j)  (2304 + 64 * (j))
#define XB_TOP      3328
#define XB_TOPGEN   3392
#define XCD_BAR_WORDS 3456
#define XB_SPIN_CAP (1u << 18)
__device__ __forceinline__ unsigned xb_ld(unsigned* p)              { return __hip_atomic_load(p, __ATOMIC_RELAXED, __HIP_MEMORY_SCOPE_AGENT); }
__device__ __forceinline__ unsigned xb_add(unsigned* p, unsigned v) { return __hip_atomic_fetch_add(p, v, __ATOMIC_RELAXED, __HIP_MEMORY_SCOPE_AGENT); }
__device__ __forceinline__ unsigned xb_xcc_id() { return (unsigned)__builtin_amdgcn_s_getreg((3 << 11) | 20) & 0xFu; }
#define XB_SPIN(cond, bar) do { unsigned _sp = 0; while (cond) { __builtin_amdgcn_s_sleep(1); \
    if ((++_sp & 255u) == 0u) { if (xb_ld(&(bar)[XB_TMO])) break; if (_sp > XB_SPIN_CAP) { atomicAdd(&(bar)[XB_TMO], 1u); break; } } } } while (0)
struct XcdBarrier { unsigned* bar; unsigned x; volatile LAS unsigned* st; };
__device__ __forceinline__ XcdBarrier xcd_barrier_post(unsigned* bar, volatile LAS unsigned* st) {
    XcdBarrier b; b.bar = bar; b.x = xb_xcc_id(); b.st = st;
    if (threadIdx.x == 0) (void)xb_add(&bar[XB_XCNT(b.x)], 1u);
    return b;
}
__device__ __forceinline__ void xcd_barrier_complete(unsigned* bar, unsigned x, unsigned& nloc, unsigned& nx) {
    const unsigned G = gridDim.x * gridDim.y * gridDim.z;
    unsigned sum, cnt, mine, sp = 0u;
    for (;;) {
        sum = 0u; cnt = 0u; mine = 0u;
#pragma unroll
        for (unsigned j = 0; j < 16; ++j) { const unsigned c = xb_ld(&bar[XB_XCNT(j)]); sum += c; cnt += (c > 0u) ? 1u : 0u; mine = (j == x) ? c : mine; }
        if (sum == G) break;
        __builtin_amdgcn_s_sleep(1);
        if ((++sp & 255u) == 0u) { if (xb_ld(&bar[XB_TMO])) break; if (sp > XB_SPIN_CAP) { atomicAdd(&bar[XB_TMO], 1u); break; } }
    }
    nloc = mine > 0u ? mine : 1u; nx = cnt > 0u ? cnt : 1u;
}
__device__ __forceinline__ void xcd_barrier(const XcdBarrier& b) {
    asm volatile("s_waitcnt vmcnt(0)" ::: "memory");
    __syncthreads();
    if (threadIdx.x == 0) {
        unsigned* bar = b.bar;
        __builtin_amdgcn_s_waitcnt(0);
        unsigned nloc = b.st[0], nx = b.st[1];
        if (nloc == 0u) { xcd_barrier_complete(bar, b.x, nloc, nx); b.st[0] = nloc; b.st[1] = nx; }
        const unsigned old = xb_add(&bar[XB_XSUB(b.x)], 1u);
        const unsigned gen = old / nloc;
        if (old + 1u == (gen + 1u) * nloc) {
            __builtin_amdgcn_fence(__ATOMIC_RELEASE, "agent");
            asm volatile("s_waitcnt vmcnt(0)" ::: "memory");
            const unsigned og = xb_add(&bar[XB_TOP], 1u);
            const unsigned tg = og / nx;
            if (og + 1u == (tg + 1u) * nx) xb_add(&bar[XB_TOPGEN], 1u);
            else XB_SPIN(xb_ld(&bar[XB_TOPGEN]) == tg, bar);
            __builtin_amdgcn_fence(__ATOMIC_ACQUIRE, "agent");
            xb_add(&bar[XB_XGEN(b.x)], 1u);
            asm volatile("s_waitcnt vmcnt(0)" ::: "memory");
        } else {
            XB_SPIN(xb_ld(&bar[XB_XGEN(b.x)]) == gen, bar);
            __builtin_amdgcn_fence(__ATOMIC_ACQUIRE, "agent");
            asm volatile("s_waitcnt vmcnt(0)" ::: "memory");
        }
    }
    __syncthreads();
}

namespace pg8 {
constexpr int BM = 256, BK = 64, HALF = 128, HTB = HALF * BK * 2, STAGE_BYTES = 8 * HTB, NXCD = 8, WGM = 8;
DI int lds_byte(int r, int c) { const int st = (r >> 4) * 2 + (c >> 5), rr = r & 15, cc = c & 31, ob = rr * 64 + cc * 2; return st * 1024 + (ob ^ (((ob >> 9) & 1) << 5)); }
DI void stage_rc(int b, int& R, int& C) { const int st = b / 1024, sb = b % 1024, swz = sb ^ (((sb >> 9) & 1) << 5); R = (st >> 1) * 16 + swz / 64; C = (st & 1) * 32 + (swz % 64) / 2; }
DI int perm32(int rho) { const int n = rho >> 4, i = rho & 15; return 8 * (i >> 2) + 4 * n + (i & 3); }
struct Unit { int pm, pn, pb; };
struct Gemm { const bf16_t* A; const bf16_t* Bt; int K; };

struct StaticOrder {
    int nM, nN, nwg, G, c;
    DI void init(int M, int N, int G_, int c_) { nM = M / BM; nN = N / BM; nwg = nM * nN; G = G_; c = c_; }
    DI bool next(int i, Unit& u) const {
        const long L = (long)i * G + c; if (L >= nwg) return false;
        int wgid = (int)L; { const int q = nwg / NXCD, r = nwg % NXCD, xcd = wgid % NXCD, off = wgid / NXCD; wgid = (xcd < r ? xcd * (q + 1) : r * (q + 1) + (xcd - r) * q) + off; }
        const int nig = WGM * nN, gid = wgid / nig, fm = gid * WGM, gsz = (nM - fm) < WGM ? (nM - fm) : WGM;
        u.pm = fm + ((wgid % nig) % gsz); u.pn = (wgid % nig) / gsz; u.pb = u.pn; return true;
    }
    DI int arow(const Unit& u, int r) const { return u.pm * BM + r; }
};
template <bool GATHER> struct MoeOrder {
    int ntot, nct, G, c; const LAS int* tinfo; const int* rows;
    DI bool next(int i, Unit& u) const {
        const int L = i * G + c; if (L >= ntot) return false;
        const int rt = L / nct, pn = L - rt * nct; u.pm = rt; u.pn = pn; u.pb = tinfo[rt * 4] * nct + pn; return true;
    }
    DI int arow(const Unit& u, int r) const {
        if constexpr (GATHER) { const int base = tinfo[u.pm * 4 + 1], nv = tinfo[u.pm * 4 + 2]; return r < nv ? rows[base + r] : 0; }
        else return u.pm * BM + r;
    }
};

struct EpiBf16 {
    static constexpr bool PERM = true;
    bf16_t* O; int ldc;
    DI void operator()(const f32x4 (&acc)[2][2][4][2], const Unit& u, int wr, int wc, int fr, int fq) const {
        const int row0 = u.pm * BM + wr * 64 + fr, col0 = u.pn * BM + wc * 32 + 8 * fq;
#pragma unroll
        for (int ai = 0; ai < 2; ++ai)
#pragma unroll
            for (int m = 0; m < 4; ++m) { bf16_t* rowp = O + (size_t)(row0 + ai * HALF + m * 16) * ldc + col0;
#pragma unroll
                for (int bj = 0; bj < 2; ++bj) { const f32x4 v0 = acc[ai][bj][m][0], v1 = acc[ai][bj][m][1];
                    u32x4 w; w.x = cvtpk(v0[0], v0[1]); w.y = cvtpk(v0[2], v0[3]); w.z = cvtpk(v1[0], v1[1]); w.w = cvtpk(v1[2], v1[3]);
                    *(u32x4*)(rowp + bj * HALF) = w; } }
    }
};
struct EpiF32 {
    static constexpr bool PERM = false;
    const float* base; float* C; int ldc;
    DI void operator()(const f32x4 (&acc)[2][2][4][2], const Unit& u, int wr, int wc, int fr, int fq) const {
        const int row0 = u.pm * BM + wr * 64 + fr, col0 = u.pn * BM + wc * 32 + 4 * fq;
#pragma unroll
        for (int ai = 0; ai < 2; ++ai)
#pragma unroll
            for (int m = 0; m < 4; ++m) { const size_t off = (size_t)(row0 + ai * HALF + m * 16) * ldc + col0;
#pragma unroll
                for (int bj = 0; bj < 2; ++bj)
#pragma unroll
                    for (int n = 0; n < 2; ++n) { f32x4 v = acc[ai][bj][m][n]; if (base) v += *(const f32x4*)(base + off + bj * HALF + n * 16);
                        *(f32x4*)(C + off + bj * HALF + n * 16) = v; } }
    }
};
struct EpiSwiglu {
    static constexpr bool PERM = true;
    bf16_t* O;
    DI void operator()(const f32x4 (&acc)[2][2][4][2], const Unit& u, int wr, int wc, int fr, int fq) const {
        const int row0 = u.pm * BM + wr * 64 + fr, col0 = u.pn * HALF + wc * 32 + 8 * fq;
#pragma unroll
        for (int ai = 0; ai < 2; ++ai)
#pragma unroll
            for (int m = 0; m < 4; ++m) { bf16_t* rowp = O + (size_t)(row0 + ai * HALF + m * 16) * DEXP + col0;
                float h[8];
#pragma unroll
                for (int n = 0; n < 2; ++n)
#pragma unroll
                    for (int j = 0; j < 4; ++j) { const float gt = acc[ai][0][m][n][j], up = acc[ai][1][m][n][j];
                        h[n * 4 + j] = gt * __builtin_amdgcn_rcpf(1.0f + __builtin_amdgcn_exp2f(-gt * LOG2E)) * up; }
                u32x4 w; w.x = cvtpk(h[0], h[1]); w.y = cvtpk(h[2], h[3]); w.z = cvtpk(h[4], h[5]); w.w = cvtpk(h[6], h[7]);
                *(u32x4*)rowp = w; }
    }
};

template <class Epi, class Sched>
DI void gemm_phase(LAS unsigned char* lds, const Gemm g, const Sched& S, const Epi& E) {
    const int tid = threadIdx.x, wid = __builtin_amdgcn_readfirstlane(tid >> 6), lane = tid & 63, wr = wid >> 2, wc = wid & 3, fr = lane & 15, fq = lane >> 4;
    const int K = g.K, nt = K / BK;
    int Ra[2]; unsigned Ca[2], voffB[2];
#pragma unroll
    for (int i = 0; i < 2; ++i) { int R, C; stage_rc(tid * 16 + i * 8192, R, C); const int Rb = Epi::PERM ? ((R & ~31) + perm32(R & 31)) : R;
        Ra[i] = R; Ca[i] = (unsigned)C * 2u; voffB[i] = (unsigned)(Rb * K + C) * 2u; }
    const unsigned rowB = (unsigned)K * 2u;
    const size_t kstep = (size_t)(BK * 2);
    const size_t hstep = (size_t)HALF * K * 2;
    const size_t tstep = 2 * hstep;
    const unsigned ldsw = (unsigned)wid * 1024u;
    const int aoff = lds_byte(wr * 64 + fr, fq * 8), boff = lds_byte(wc * 32 + fr, fq * 8);
#define PG8_SA(b, h) (((b) * 2 + (h)) * HTB)
#define PG8_SB(b, h) ((4 + (b) * 2 + (h)) * HTB)
#define PG8_STAGE(bufoff, gbase, voff) do { _Pragma("unroll") for (int _i = 0; _i < 2; ++_i) \
        __builtin_amdgcn_global_load_lds((const unsigned*)((const char*)(gbase) + (voff)[_i]), (LAS unsigned*)(lds + (bufoff) + ldsw + _i * 8192), 16, 0, 0); } while (0)
#define PG8_LDA(dst, b, h) do { _Pragma("unroll") for (int m = 0; m < 4; ++m) _Pragma("unroll") for (int k = 0; k < 2; ++k) dst[m][k] = *(const LAS bf16x8*)(lds + PG8_SA(b, h) + aoff + m * 2048 + k * 1024); } while (0)
#define PG8_LDB(dst, b, h) do { _Pragma("unroll") for (int n = 0; n < 2; ++n) _Pragma("unroll") for (int k = 0; k < 2; ++k) dst[n][k] = *(const LAS bf16x8*)(lds + PG8_SB(b, h) + boff + n * 2048 + k * 1024); } while (0)
#define PG8_MMA(ai, bj, At, Bt) do { __builtin_amdgcn_s_setprio(1); _Pragma("unroll") for (int m = 0; m < 4; ++m) _Pragma("unroll") for (int n = 0; n < 2; ++n) _Pragma("unroll") for (int k = 0; k < 2; ++k) \
        acc[ai][bj][m][n] = __builtin_amdgcn_mfma_f32_16x16x32_bf16(Bt[n][k], At[m][k], acc[ai][bj][m][n], 0, 0, 0); __builtin_amdgcn_s_setprio(0); } while (0)
#define PG8_WAIT_V(n) asm volatile("s_waitcnt vmcnt(" #n ")" ::: "memory")
#define PG8_WAIT_L(n) asm volatile("s_waitcnt lgkmcnt(" #n ")" ::: "memory")
#define PG8_BAR __builtin_amdgcn_s_barrier()
#define PG8_SCHED __builtin_amdgcn_sched_barrier(0)
#define PG8_MKVA(dst, u) do { _Pragma("unroll") for (int _h = 0; _h < 2; ++_h) _Pragma("unroll") for (int _i = 0; _i < 2; ++_i) \
        dst[_h][_i] = (unsigned)S.arow(u, _h * HALF + Ra[_i]) * rowB + Ca[_i]; } while (0)
    Unit cur, nxt; int ui = 0;
    if (!S.next(0, cur)) return;
    f32x4 acc[2][2][4][2];
#pragma unroll
    for (int a = 0; a < 2; ++a)
#pragma unroll
        for (int b = 0; b < 2; ++b)
#pragma unroll
            for (int m = 0; m < 4; ++m)
#pragma unroll
                for (int n = 0; n < 2; ++n) acc[a][b][m][n] = (f32x4){0.f, 0.f, 0.f, 0.f};
    bf16x8 At[4][2], B0[2][2], B1[2][2];
    const char* Ab = (const char*)g.A;
    unsigned va[2][2], nva[2][2];
    PG8_MKVA(va, cur);
    const char* cB = (const char*)g.Bt + (size_t)cur.pb * tstep;
    PG8_STAGE(PG8_SB(0, 0), cB, voffB); PG8_STAGE(PG8_SA(0, 0), Ab, va[0]); PG8_STAGE(PG8_SB(0, 1), cB + hstep, voffB); PG8_STAGE(PG8_SA(0, 1), Ab, va[1]);
    if (wr == 1) PG8_BAR;
    PG8_WAIT_V(4); PG8_BAR;
    PG8_STAGE(PG8_SB(1, 0), cB + kstep, voffB); PG8_STAGE(PG8_SA(1, 0), Ab + kstep, va[0]); PG8_STAGE(PG8_SB(1, 1), cB + hstep + kstep, voffB);
    PG8_WAIT_V(6); PG8_BAR;
    for (;;) {
        const bool has_next = S.next(ui + 1, nxt);
        if (has_next) { PG8_MKVA(nva, nxt); } else {
#pragma unroll
            for (int h = 0; h < 2; ++h)
#pragma unroll
                for (int i = 0; i < 2; ++i) nva[h][i] = va[h][i]; }
        const char* nB = has_next ? (const char*)g.Bt + (size_t)nxt.pb * tstep : cB;
        for (int t = 0; t < nt; t += 2) {
            const bool last = (t == nt - 2);
            const char* a1 = Ab + (size_t)(t + 1) * kstep;
            const char* a2 = last ? Ab : Ab + (size_t)(t + 2) * kstep; const char* b2 = last ? nB : cB + (size_t)(t + 2) * kstep;
            const char* a3 = a2 + kstep; const char* b3 = b2 + kstep;
            unsigned xa[2][2];
#pragma unroll
            for (int h = 0; h < 2; ++h)
#pragma unroll
                for (int i = 0; i < 2; ++i) xa[h][i] = last ? nva[h][i] : va[h][i];
            PG8_LDB(B0, 0, 0); PG8_SCHED; PG8_LDA(At, 0, 0); PG8_STAGE(PG8_SA(1, 1), a1, va[1]);
            PG8_WAIT_L(8); PG8_BAR; PG8_WAIT_L(0); PG8_MMA(0, 0, At, B0); PG8_BAR; PG8_SCHED;
            PG8_LDB(B1, 0, 1); PG8_STAGE(PG8_SB(0, 0), b2, voffB);
            PG8_BAR; PG8_WAIT_L(0); PG8_MMA(0, 1, At, B1); PG8_BAR;
            PG8_LDA(At, 0, 1); PG8_STAGE(PG8_SA(0, 0), a2, xa[0]);
            PG8_BAR; PG8_WAIT_L(0); PG8_MMA(1, 0, At, B0); PG8_BAR; PG8_SCHED;
            PG8_STAGE(PG8_SB(0, 1), b2 + hstep, voffB);
            PG8_WAIT_V(6); PG8_BAR; PG8_MMA(1, 1, At, B1); PG8_BAR;
            PG8_LDB(B0, 1, 0); PG8_SCHED; PG8_LDA(At, 1, 0); PG8_STAGE(PG8_SA(0, 1), a2, xa[1]);
            PG8_WAIT_L(8); PG8_BAR; PG8_WAIT_L(0); PG8_MMA(0, 0, At, B0); PG8_BAR; PG8_SCHED;
            PG8_LDB(B1, 1, 1); PG8_STAGE(PG8_SB(1, 0), b3, voffB);
            PG8_BAR; PG8_WAIT_L(0); PG8_MMA(0, 1, At, B1); PG8_BAR;
            PG8_LDA(At, 1, 1); PG8_STAGE(PG8_SA(1, 0), a3, xa[0]);
            PG8_BAR; PG8_WAIT_L(0); PG8_MMA(1, 0, At, B0); PG8_BAR; PG8_SCHED;
            PG8_STAGE(PG8_SB(1, 1), b3 + hstep, voffB);
            PG8_WAIT_V(6); PG8_BAR; PG8_MMA(1, 1, At, B1); PG8_BAR;
        }
        E(acc, cur, wr, wc, fr, fq);
        if (!has_next) break;
#pragma unroll
        for (int a = 0; a < 2; ++a)
#pragma unroll
            for (int b = 0; b < 2; ++b)
#pragma unroll
                for (int m = 0; m < 4; ++m)
#pragma unroll
                    for (int n = 0; n < 2; ++n) acc[a][b][m][n] = (f32x4){0.f, 0.f, 0.f, 0.f};
        cur = nxt; cB = nB; ++ui;
#pragma unroll
        for (int h = 0; h < 2; ++h)
#pragma unroll
            for (int i = 0; i < 2; ++i) va[h][i] = nva[h][i];
    }
    PG8_WAIT_V(0);
    if (wr == 0) PG8_BAR;
    PG8_BAR;
#undef PG8_SA
#undef PG8_SB
#undef PG8_STAGE
#undef PG8_LDA
#undef PG8_LDB
#undef PG8_MMA
#undef PG8_WAIT_V
#undef PG8_WAIT_L
#undef PG8_BAR
#undef PG8_SCHED
#undef PG8_MKVA
}
}

namespace at {
constexpr int SHM = 16384;
constexpr int L_V = 0, L_K = SHM, L_IMP = 2 * SHM, L_WS = L_IMP + 32768, L_SEL = L_WS + 8 * 512, L_UNI = L_SEL + 8192, L_FLAG = L_UNI + 128;
#define KSWZ(row, colB) ((row) * 256 + ((colB) ^ (((row) & 7) << 4)))
#define SBAR() __builtin_amdgcn_sched_barrier(0)
DI int v_st(int k, int c) { const int kk = (k & ~0xC) | ((k & 4) << 1) | ((k & 8) >> 1); return ((kk >> 3) * 4 + (c >> 5)) * 512 + ((kk & 7) * 32 + (c & 31)) * 2; }
DI int v_rd_base(int lane) { return ((lane & 3) << 3) | (((lane >> 2) & 3) << 6) | (((lane >> 4) & 1) << 5) | (((lane >> 5) & 1) << 8); }
constexpr int v_rd_off(int d0, int ks, int half) { return d0 * 512 + ks * 4096 + half * 2048; }
DI int crow(int r, int hi) { return (r & 3) + 8 * (r >> 2) + 4 * hi; }

DI void qkt(f32x16& p0, f32x16& p1, const LAS char* K_lds, int r32, int hi, const bf16x8* qr) {
    p0 = f32x16{}; p1 = f32x16{};
    const LAS char* kb[4];
#pragma unroll
    for (int dd = 0; dd < 4; ++dd) kb[dd] = K_lds + KSWZ(r32, (dd * 16 + hi * 8) * 2);
#pragma unroll
    for (int d0 = 0; d0 < 8; ++d0) { const LAS char* a = kb[d0 & 3] + (d0 >> 2) * 128;
        const bf16x8 b0 = *(const LAS bf16x8*)a;
        const bf16x8 b1 = *(const LAS bf16x8*)(a + 32 * 256);
        p0 = __builtin_amdgcn_mfma_f32_32x32x16_bf16(b0, qr[d0], p0, 0, 0, 0);
        p1 = __builtin_amdgcn_mfma_f32_32x32x16_bf16(b1, qr[d0], p1, 0, 0, 0); }
}
DI void pv_tile(f32x16* o, int vb0, bf16x8 pa0, bf16x8 pa1, bf16x8 pa2, bf16x8 pa3) {
#define TRRD(dst, off) asm volatile("ds_read_b64_tr_b16 %0, %1 offset:%2" : "=&v"(dst) : "v"(vb0), "i"(off) : "memory")
#define PV_D0(d0) do { s16x4 l0, l1, l2, l3, h0, h1, h2, h3; constexpr int b_ = v_rd_off(d0, 0, 0); \
        TRRD(l0, b_); TRRD(h0, b_ + 2048); TRRD(l1, b_ + 4096); TRRD(h1, b_ + 6144); TRRD(l2, b_ + 8192); TRRD(h2, b_ + 10240); TRRD(l3, b_ + 12288); TRRD(h3, b_ + 14336); \
        asm volatile("s_waitcnt lgkmcnt(0)" ::: "memory"); SBAR(); \
        o[d0] = __builtin_amdgcn_mfma_f32_32x32x16_bf16(pa0, (bf16x8){l0[0], l0[1], l0[2], l0[3], h0[0], h0[1], h0[2], h0[3]}, o[d0], 0, 0, 0); \
        o[d0] = __builtin_amdgcn_mfma_f32_32x32x16_bf16(pa1, (bf16x8){l1[0], l1[1], l1[2], l1[3], h1[0], h1[1], h1[2], h1[3]}, o[d0], 0, 0, 0); \
        o[d0] = __builtin_amdgcn_mfma_f32_32x32x16_bf16(pa2, (bf16x8){l2[0], l2[1], l2[2], l2[3], h2[0], h2[1], h2[2], h2[3]}, o[d0], 0, 0, 0); \
        o[d0] = __builtin_amdgcn_mfma_f32_32x32x16_bf16(pa3, (bf16x8){l3[0], l3[1], l3[2], l3[3], h3[0], h3[1], h3[2], h3[3]}, o[d0], 0, 0, 0); } while (0)
    PV_D0(0); PV_D0(1); PV_D0(2); PV_D0(3);
#undef PV_D0
#undef TRRD
}
DI void pack_p(const f32x16& p0, const f32x16& p1, bf16x8& pa0, bf16x8& pa1, bf16x8& pa2, bf16x8& pa3) {
#define PK4(P, B_, OUT) do { unsigned a0 = cvtpk(P[B_+0], P[B_+1]), a1 = cvtpk(P[B_+2], P[B_+3]); \
        unsigned b0 = cvtpk(P[B_+4], P[B_+5]), b1 = cvtpk(P[B_+6], P[B_+7]); \
        auto r0 = __builtin_amdgcn_permlane32_swap(a0, b0, false, false); auto r1 = __builtin_amdgcn_permlane32_swap(a1, b1, false, false); \
        u32x4 w = {r0[0], r1[0], r0[1], r1[1]}; OUT = __builtin_bit_cast(bf16x8, w); } while (0)
    PK4(p0, 0, pa0); PK4(p0, 8, pa1); PK4(p1, 0, pa2); PK4(p1, 8, pa3);
#undef PK4
}
DI float half_max(float v) { auto rr = __builtin_amdgcn_permlane32_swap(__float_as_uint(v), __float_as_uint(v), false, false); return fmaxf(__uint_as_float(rr[0]), __uint_as_float(rr[1])); }
DI float half_sum(float v) { auto rr = __builtin_amdgcn_permlane32_swap(__float_as_uint(v), __float_as_uint(v), false, false); return __uint_as_float(rr[0]) + __uint_as_float(rr[1]); }

struct TileRegs { bf16x8 k0, k1, v0, v1; };
template <bool NEEDV> DI void tile_load(TileRegs& R, const bf16_t* Kp, const bf16_t* Vp, size_t pitchK, size_t pitchV, int sr, int sc) {
    R.k0 = *(const bf16x8*)(Kp + (size_t)sr * pitchK + sc); R.k1 = *(const bf16x8*)(Kp + (size_t)(sr + 32) * pitchK + sc);
    if (NEEDV) { R.v0 = *(const bf16x8*)(Vp + (size_t)sr * pitchV + sc); R.v1 = *(const bf16x8*)(Vp + (size_t)(sr + 32) * pitchV + sc); }
}
template <bool NEEDV> DI void tile_write(LAS char* lds, const TileRegs& R, int sr, int sc) {
    const int kws = KSWZ(sr, sc * 2);
    *(LAS bf16x8*)(lds + L_K + kws) = R.k0; *(LAS bf16x8*)(lds + L_K + kws + 32 * 256) = R.k1;
    if (NEEDV) { *(LAS bf16x8*)(lds + L_V + v_st(sr, sc)) = R.v0; *(LAS bf16x8*)(lds + L_V + v_st(32 + sr, sc)) = R.v1; }
}
DI unsigned wave_max_u32(unsigned x) { for (int o = 32; o >= 1; o >>= 1) { const unsigned y = (unsigned)__shfl_xor((int)x, o); x = x > y ? x : y; } return x; }

enum { M_CMP1 = 0, M_CMP2 = 1, M_SLC = 2, M_WIN = 3 };

struct NsaCtx {
    LAS char* lds; int tid, wid, lane, r32, hi, sr, sc, vb0;
    int b, g, t0, t;
    float slope2;
    const bf16_t* proj; const bf16_t* kcmp; const bf16_t* vcmp;
    unsigned sel0, sel1, sel2, sel3;
};

template <int MODE>
DI void nsa_pass(const NsaCtx& c, const bf16x8* qr, f32x16* o, float& m_reg, float& l_reg, float inv_l, int nt_or_jlo, int jhi, const unsigned* uni) {
    constexpr bool NEEDV = (MODE != M_CMP1);
    const size_t rowbase = (size_t)c.b * T_;
    const bf16_t* Kb; const bf16_t* Vb; size_t pitch;
    if (MODE == M_CMP1 || MODE == M_CMP2) { Kb = c.kcmp + (size_t)(c.b * 4 + c.g) * 512 * 128; Vb = c.vcmp + (size_t)(c.b * 4 + c.g) * 512 * 128; pitch = 128; }
    else if (MODE == M_SLC) { Kb = c.proj + rowbase * LDP0 + C_KS + c.g * 128; Vb = c.proj + rowbase * LDP0 + C_VS + c.g * 128; pitch = LDP0; }
    else { Kb = c.proj + rowbase * LDP0 + C_KW + c.g * 128; Vb = c.proj + rowbase * LDP0 + C_VW + c.g * 128; pitch = LDP0; }
    LAS float* ws = (LAS float*)(c.lds + L_WS) + c.wid * 128;
    LAS float* imp = (LAS float*)(c.lds + L_IMP) + c.wid * 1024;
    unsigned u0 = 0, u1 = 0, u2 = 0, u3 = 0; int j = 0, jn = 0; bool have, haven;
    if (MODE == M_SLC) { u0 = uni[0]; u1 = uni[1]; u2 = uni[2]; u3 = uni[3]; }
#define NEXT_SLC(jj, hv) do { if (u0) { jj = __builtin_ctz(u0); u0 &= u0 - 1; hv = true; } else if (u1) { jj = 32 + __builtin_ctz(u1); u1 &= u1 - 1; hv = true; } \
        else if (u2) { jj = 64 + __builtin_ctz(u2); u2 &= u2 - 1; hv = true; } else if (u3) { jj = 96 + __builtin_ctz(u3); u3 &= u3 - 1; hv = true; } else hv = false; } while (0)
    if (MODE == M_SLC) { NEXT_SLC(j, have); } else if (MODE == M_WIN) { j = nt_or_jlo; have = j <= jhi; } else { j = 0; have = j < nt_or_jlo; }
    TileRegs R;
    if (have) tile_load<NEEDV>(R, Kb + (size_t)j * 64 * pitch, Vb + (size_t)j * 64 * pitch, pitch, pitch, c.sr, c.sc);
    const int twmax = c.t0 + c.wid * 8 + 7;
    while (have) {
        __syncthreads();
        tile_write<NEEDV>(c.lds, R, c.sr, c.sc);
        __syncthreads();
        if (MODE == M_SLC) { NEXT_SLC(jn, haven); } else if (MODE == M_WIN) { jn = j + 1; haven = jn <= jhi; } else { jn = j + 1; haven = jn < nt_or_jlo; }
        if (haven) tile_load<NEEDV>(R, Kb + (size_t)jn * 64 * pitch, Vb + (size_t)jn * 64 * pitch, pitch, pitch, c.sr, c.sc);
        bool act; unsigned selbit = 0;
        if (MODE == M_CMP1 || MODE == M_CMP2) act = (j * 1024 + 31) <= twmax;
        else if (MODE == M_SLC) { const unsigned wsel = (j < 32) ? c.sel0 : (j < 64) ? c.sel1 : (j < 96) ? c.sel2 : c.sel3; selbit = (wsel >> (j & 31)) & 1u; act = __any(selbit != 0u); }
        else act = true;
        if (act) {
            f32x16 p0, p1;
            qkt(p0, p1, c.lds + L_K, c.r32, c.hi, qr);
            const float NEG = -__builtin_inff();
            if (MODE == M_CMP1 || MODE == M_CMP2) {
                const int dq = c.t - 31 - 1024 * j - 64 * c.hi; const float base = -c.slope2 * (float)dq, s16 = c.slope2 * 16.f;
#pragma unroll
                for (int r = 0; r < 16; ++r) { const int cc = (r & 3) + 8 * (r >> 2);
                    p0[r] = (dq - 16 * cc >= 0) ? fmaf(s16, (float)cc, p0[r] + base) : NEG;
                    p1[r] = (dq - 16 * cc - 512 >= 0) ? fmaf(s16, (float)(cc + 32), p1[r] + base) : NEG; }
            } else {
                const int dq = c.t - 64 * j - 4 * c.hi; const float base = -c.slope2 * (float)dq;
#pragma unroll
                for (int r = 0; r < 16; ++r) { const int cc = (r & 3) + 8 * (r >> 2);
                    bool v0, v1;
                    if (MODE == M_SLC) { v0 = selbit && (dq - cc >= 0); v1 = selbit && (dq - cc - 32 >= 0); }
                    else { v0 = (unsigned)(dq - cc) < 512u; v1 = (unsigned)(dq - cc - 32) < 512u; }
                    p0[r] = v0 ? fmaf(c.slope2, (float)cc, p0[r] + base) : NEG;
                    p1[r] = v1 ? fmaf(c.slope2, (float)(cc + 32), p1[r] + base) : NEG; }
            }
            if (MODE == M_CMP2) {
#pragma unroll
                for (int r = 0; r < 16; ++r) { p0[r] = __builtin_amdgcn_exp2f(p0[r] - m_reg) * inv_l; p1[r] = __builtin_amdgcn_exp2f(p1[r] - m_reg) * inv_l; }
                const int q8 = c.r32 >> 2; const bool owner = (c.r32 & 3) == 0;
#pragma unroll
                for (int hf = 0; hf < 2; ++hf)
#pragma unroll
                    for (int gi = 0; gi < 4; ++gi) {
                        const float x0 = hf ? p1[4 * gi] : p0[4 * gi], x1 = hf ? p1[4 * gi + 1] : p0[4 * gi + 1], x2 = hf ? p1[4 * gi + 2] : p0[4 * gi + 2], x3 = hf ? p1[4 * gi + 3] : p0[4 * gi + 3];
                        float cy = 0.5f * x3, w = (x0 + x1) + (x2 + cy);
                        w += __shfl_xor(w, 1); w += __shfl_xor(w, 2); cy += __shfl_xor(cy, 1); cy += __shfl_xor(cy, 2);
                        const int js = j * 16 + hf * 8 + 2 * gi + c.hi;
                        if (owner) imp[q8 * 128 + js] += w;
                        asm volatile("s_waitcnt lgkmcnt(0)" ::: "memory");
                        if (owner && js + 1 < 128) imp[q8 * 128 + js + 1] += cy;
                        asm volatile("s_waitcnt lgkmcnt(0)" ::: "memory");
                    }
                bf16x8 pa0, pa1, pa2, pa3; pack_p(p0, p1, pa0, pa1, pa2, pa3);
                pv_tile(o, c.vb0, pa0, pa1, pa2, pa3);
            } else {
                float pmax = p0[0];
#pragma unroll
                for (int r = 1; r < 16; ++r) pmax = fmaxf(pmax, p0[r]);
#pragma unroll
                for (int r = 0; r < 16; ++r) pmax = fmaxf(pmax, p1[r]);
                pmax = half_max(pmax);
                const float mn = fmaxf(m_reg, pmax), alpha = __builtin_amdgcn_exp2f(m_reg - mn); m_reg = mn;
                float ps = 0.f;
#pragma unroll
                for (int r = 0; r < 16; ++r) { p0[r] = __builtin_amdgcn_exp2f(p0[r] - mn); p1[r] = __builtin_amdgcn_exp2f(p1[r] - mn); ps += p0[r] + p1[r]; }
                ps = half_sum(ps);
                l_reg = l_reg * alpha + ps;
                if (MODE != M_CMP1) {
                    if (__any(alpha < 1.f)) { if (c.hi == 0) ws[32 + c.r32] = alpha; asm volatile("s_waitcnt lgkmcnt(0)" ::: "memory");
#pragma unroll
                        for (int r = 0; r < 16; ++r) { const float a = ws[32 + crow(r, c.hi)];
#pragma unroll
                            for (int d = 0; d < 4; ++d) o[d][r] *= a; } }
                    bf16x8 pa0, pa1, pa2, pa3; pack_p(p0, p1, pa0, pa1, pa2, pa3);
                    pv_tile(o, c.vb0, pa0, pa1, pa2, pa3);
                }
            }
        }
        j = jn; have = haven;
    }
#undef NEXT_SLC
}

template <bool ACCUM> DI void nsa_store(const NsaCtx& c, const f32x16* o, float rowscale, bf16_t* att) {
    LAS float* ws = (LAS float*)(c.lds + L_WS) + c.wid * 128;
    if (c.hi == 0) ws[c.r32] = rowscale;
    asm volatile("s_waitcnt lgkmcnt(0)" ::: "memory");
#pragma unroll
    for (int r = 0; r < 16; ++r) { const int row = crow(r, c.hi); const float s = ws[row]; const int tq = c.t0 + c.wid * 8 + (row >> 2), hd = c.g * 4 + (row & 3);
        bf16_t* op = att + (size_t)(c.b * T_ + tq) * DM + hd * 128;
#pragma unroll
        for (int d0 = 0; d0 < 4; ++d0) { float v = o[d0][r] * s; float vn = __shfl_xor(v, 1);
            if ((c.r32 & 1) == 0) { unsigned* p = (unsigned*)(op + d0 * 32 + c.r32);
                if (ACCUM) { const unsigned prev = *p; v += bflo(prev); vn += bfhi(prev); }
                *p = cvtpk(v, vn); } } }
    asm volatile("s_waitcnt lgkmcnt(0)" ::: "memory");
}
DI void nsa_setup(NsaCtx& c, LAS char* lds, int item, const bf16_t* proj, const bf16_t* kcmp, const bf16_t* vcmp, const float* qk_gain, bf16x8* qr, float* gate) {
    c.lds = lds; c.tid = threadIdx.x; c.wid = __builtin_amdgcn_readfirstlane(c.tid >> 6); c.lane = c.tid & 63; c.r32 = c.lane & 31; c.hi = c.lane >> 5;
    c.sr = c.tid >> 4; c.sc = (c.tid & 15) * 8; c.vb0 = (int)(unsigned)(uintptr_t)(lds + L_V) + v_rd_base(c.lane);
    c.b = item >> 9; c.g = (item >> 7) & 3; c.t0 = (item & 127) * 64;
    c.proj = proj; c.kcmp = kcmp; c.vcmp = vcmp;
    const int q8 = c.r32 >> 2, hr = c.r32 & 3, head = c.g * 4 + hr; c.t = c.t0 + c.wid * 8 + q8;
    c.slope2 = __builtin_amdgcn_exp2f(-0.5f * (float)(head + 1)) * LOG2E;
    const size_t tokrow = (size_t)(c.b * T_ + c.t) * LDP0;
    float qf[64]; float ss = 0.f;
    const bf16_t* qp = proj + tokrow + C_Q + head * 128 + c.hi * 8;
#pragma unroll
    for (int d0 = 0; d0 < 8; ++d0) { const u32x4 raw = *(const u32x4*)(qp + d0 * 16);
#pragma unroll
        for (int e = 0; e < 4; ++e) { const float a = bflo(raw[e]), bq = bfhi(raw[e]); qf[d0 * 8 + 2 * e] = a; qf[d0 * 8 + 2 * e + 1] = bq; ss += a * a + bq * bq; } }
    ss = half_sum(ss);
    const float rs = __builtin_amdgcn_rsqf(ss * (1.0f / 128.0f) + 1e-6f) * (QSCALE * LOG2E);
#pragma unroll
    for (int d0 = 0; d0 < 8; ++d0) { const float* gp = qk_gain + d0 * 16 + c.hi * 8; const f32x4 g0 = *(const f32x4*)gp, g1 = *(const f32x4*)(gp + 4);
        f32x4 a = {qf[d0 * 8] * rs * g0[0], qf[d0 * 8 + 1] * rs * g0[1], qf[d0 * 8 + 2] * rs * g0[2], qf[d0 * 8 + 3] * rs * g0[3]};
        f32x4 bq = {qf[d0 * 8 + 4] * rs * g1[0], qf[d0 * 8 + 5] * rs * g1[1], qf[d0 * 8 + 6] * rs * g1[2], qf[d0 * 8 + 7] * rs * g1[3]};
        qr[d0] = pack8(a, bq); }
#pragma unroll
    for (int br = 0; br < 3; ++br) { const float x = bflo((unsigned)proj[tokrow + C_GT + br * 16 + head]); gate[br] = __builtin_amdgcn_rcpf(1.0f + __builtin_amdgcn_exp2f(-x * LOG2E)); }
}
DI void nsa_cmp_item(LAS char* lds, int item, int slot, const bf16_t* proj, const bf16_t* kcmp, const bf16_t* vcmp, const float* qk_gain, bf16_t* att) {
    NsaCtx c; bf16x8 qr[8]; float gate[3];
    nsa_setup(c, lds, item, proj, kcmp, vcmp, qk_gain, qr, gate);
    LAS float* imp = (LAS float*)(lds + L_IMP) + c.wid * 1024;
#pragma unroll
    for (int i = 0; i < 16; ++i) imp[i * 64 + c.lane] = 0.f;
    LAS unsigned* selm = (LAS unsigned*)(lds + L_SEL) + slot * 256;
    LAS unsigned* uni = (LAS unsigned*)(lds + L_UNI) + slot * 4;
    if (c.tid < 4) uni[c.tid] = 0u;
    f32x16 o[4] = {};
    int nkt = ((c.t0 >> 4) + 2) / 64 + 1; if (nkt > 8) nkt = 8;
    float m_c = -1e30f, l_c = 0.f;
    nsa_pass<M_CMP1>(c, qr, o, m_c, l_c, 0.f, nkt, 0, nullptr);
    const float inv_l = l_c > 0.f ? __builtin_amdgcn_rcpf(l_c) : 0.f;
    nsa_pass<M_CMP2>(c, qr, o, m_c, l_c, inv_l, nkt, 0, nullptr);
    nsa_store<false>(c, o, gate[0], att);
    for (int q = 0; q < 8; ++q) {
        const int tq = c.t0 + c.wid * 8 + q, jd = tq >> 6;
        const float v0 = imp[q * 128 + c.lane], v1 = imp[q * 128 + 64 + c.lane];
        const int j0 = c.lane, j1 = c.lane + 64;
        unsigned k0 = j0 > jd ? 0u : (((j0 == 0 || j0 == jd) ? 0x80000000u : (((__float_as_uint(v0) >> 7) + 1u) << 7)) | (unsigned)(127 - j0));
        unsigned k1 = j1 > jd ? 0u : (((j1 == jd) ? 0x80000000u : (((__float_as_uint(v1) >> 7) + 1u) << 7)) | (unsigned)(127 - j1));
        bool s0 = false, s1 = false;
        for (int it = 0; it < 16; ++it) {
            const unsigned mx = wave_max_u32(k0 > k1 ? k0 : k1);
            if (mx == 0u) break;
            const int jw = 127 - (int)(mx & 127u);
            if (jw == j0) { s0 = true; k0 = 0u; }
            if (jw == j1) { s1 = true; k1 = 0u; }
        }
        const unsigned long long lo = __ballot(s0), hi64 = __ballot(s1);
        if (c.lane == 0) { const int qi = (c.wid * 8 + q) * 4;
            selm[qi] = (unsigned)lo; selm[qi + 1] = (unsigned)(lo >> 32); selm[qi + 2] = (unsigned)hi64; selm[qi + 3] = (unsigned)(hi64 >> 32);
            __hip_atomic_fetch_or(uni + 0, (unsigned)lo, __ATOMIC_RELAXED, __HIP_MEMORY_SCOPE_WORKGROUP); __hip_atomic_fetch_or(uni + 1, (unsigned)(lo >> 32), __ATOMIC_RELAXED, __HIP_MEMORY_SCOPE_WORKGROUP);
            __hip_atomic_fetch_or(uni + 2, (unsigned)hi64, __ATOMIC_RELAXED, __HIP_MEMORY_SCOPE_WORKGROUP); __hip_atomic_fetch_or(uni + 3, (unsigned)(hi64 >> 32), __ATOMIC_RELAXED, __HIP_MEMORY_SCOPE_WORKGROUP); }
    }
    __syncthreads();
}
DI void nsa_slc_item(LAS char* lds, int item, int slot, const bf16_t* proj, const float* qk_gain, bf16_t* att) {
    NsaCtx c; bf16x8 qr[8]; float gate[3];
    nsa_setup(c, lds, item, proj, nullptr, nullptr, qk_gain, qr, gate);
    unsigned uni[4];
    {
        const LAS unsigned* selm = (const LAS unsigned*)(lds + L_SEL) + slot * 256; const LAS unsigned* un = (const LAS unsigned*)(lds + L_UNI) + slot * 4;
#pragma unroll
        for (int i = 0; i < 4; ++i) uni[i] = (unsigned)__builtin_amdgcn_readfirstlane((int)un[i]);
        const int qi = (c.wid * 8 + (c.r32 >> 2)) * 4; c.sel0 = selm[qi]; c.sel1 = selm[qi + 1]; c.sel2 = selm[qi + 2]; c.sel3 = selm[qi + 3];
    }
    f32x16 o[4] = {};
    float m_s = -1e30f, l_s = 0.f;
    nsa_pass<M_SLC>(c, qr, o, m_s, l_s, 0.f, 0, 0, uni);
    nsa_store<true>(c, o, gate[1] * (l_s > 0.f ? __builtin_amdgcn_rcpf(l_s) : 0.f), att);
    __syncthreads();
}
DI void nsa_win_item(LAS char* lds, int item, const bf16_t* proj, const float* qk_gain, bf16_t* att) {
    NsaCtx c; bf16x8 qr[8]; float gate[3];
    nsa_setup(c, lds, item, proj, nullptr, nullptr, qk_gain, qr, gate);
    f32x16 o[4] = {};
    float m_w = -1e30f, l_w = 0.f;
    const int jhi = c.t0 >> 6, jlo = jhi - 8 > 0 ? jhi - 8 : 0;
    nsa_pass<M_WIN>(c, qr, o, m_w, l_w, 0.f, jlo, jhi, nullptr);
    nsa_store<true>(c, o, gate[2] * (l_w > 0.f ? __builtin_amdgcn_rcpf(l_w) : 0.f), att);
    __syncthreads();
}
}

namespace at {
DI void sb_item(LAS char* lds, int item, const bf16_t* proj, bf16_t* att) {
    const int tid = threadIdx.x, wid = __builtin_amdgcn_readfirstlane(tid >> 6), lane = tid & 63, r32 = lane & 31, hi = lane >> 5;
    const int sr = tid >> 4, sc = (tid & 15) * 8, vb0 = (int)(unsigned)(uintptr_t)(lds + L_V) + v_rd_base(lane);
    const int b = item >> 9, h = (item >> 5) & 15, qb = item & 31, q0 = qb * 256, t = q0 + wid * 32 + r32;
    bf16x8 qr[8];
    {
        const bf16_t* qp = proj + (size_t)(b * T_ + t) * LDP1 + h * 128 + hi * 8; const float sc2 = QSCALE * LOG2E;
#pragma unroll
        for (int d0 = 0; d0 < 8; ++d0) { const u32x4 raw = *(const u32x4*)(qp + d0 * 16);
            f32x4 a = {bflo(raw[0]) * sc2, bfhi(raw[0]) * sc2, bflo(raw[1]) * sc2, bfhi(raw[1]) * sc2}, bq = {bflo(raw[2]) * sc2, bfhi(raw[2]) * sc2, bflo(raw[3]) * sc2, bfhi(raw[3]) * sc2};
            qr[d0] = pack8(a, bq); }
    }
    LAS unsigned* flg = (LAS unsigned*)(lds + L_FLAG);
    if (tid < 8) flg[tid] = 0u;
    const bf16_t* Kb = proj + (size_t)b * T_ * LDP1 + DM + h * 128; const bf16_t* Vb = proj + (size_t)b * T_ * LDP1 + 2 * DM + h * 128;
    f32x16 o[4] = {}; float carry = 0.f; bool wdone = false;
    const int twmax = q0 + wid * 32 + 31;
    int jt = qb * 4 + 3;
    TileRegs R; tile_load<true>(R, Kb + (size_t)jt * 64 * LDP1, Vb + (size_t)jt * 64 * LDP1, LDP1, LDP1, sr, sc);
    for (;;) {
        __syncthreads();
        unsigned nd = 0;
#pragma unroll
        for (int i = 0; i < 8; ++i) nd += flg[i];
        if (__builtin_amdgcn_readfirstlane((int)nd) == 8) break;
        tile_write<true>(lds, R, sr, sc);
        __syncthreads();
        const int jn = jt - 1;
        if (jn >= 0) tile_load<true>(R, Kb + (size_t)jn * 64 * LDP1, Vb + (size_t)jn * 64 * LDP1, LDP1, LDP1, sr, sc);
        if (!wdone && 64 * jt < twmax) {
            f32x16 p0, p1;
            qkt(p0, p1, lds + L_K, r32, hi, qr);
            const int dq = t - 64 * jt - 4 * hi;
            f32x16 l0, l1;
            const float NEG = -__builtin_inff();
#pragma unroll
            for (int r = 0; r < 16; ++r) { const int cc = (r & 3) + 8 * (r >> 2);
                { const float z = p0[r]; const float sp = fmaxf(z, 0.f) + __builtin_amdgcn_logf(1.0f + __builtin_amdgcn_exp2f(-fabsf(z))); const bool v = (dq - cc) > 0; l0[r] = v ? -sp : 0.f; p0[r] = v ? z - sp : NEG; }
                { const float z = p1[r]; const float sp = fmaxf(z, 0.f) + __builtin_amdgcn_logf(1.0f + __builtin_amdgcn_exp2f(-fabsf(z))); const bool v = (dq - cc - 32) > 0; l1[r] = v ? -sp : 0.f; p1[r] = v ? z - sp : NEG; } }
            float own[8], par[8], aft[8];
#pragma unroll
            for (int gi = 0; gi < 4; ++gi) { own[gi] = (l0[4 * gi] + l0[4 * gi + 1]) + (l0[4 * gi + 2] + l0[4 * gi + 3]); own[4 + gi] = (l1[4 * gi] + l1[4 * gi + 1]) + (l1[4 * gi + 2] + l1[4 * gi + 3]); }
#pragma unroll
            for (int pi = 0; pi < 8; ++pi) par[pi] = __shfl_xor(own[pi], 32);
            float run = 0.f;
#pragma unroll
            for (int pi = 7; pi >= 0; --pi) { aft[pi] = run + (hi == 0 ? par[pi] : 0.f); run += own[pi] + par[pi]; }
#pragma unroll
            for (int gi = 0; gi < 4; ++gi) {
                { float a = carry + aft[gi]; p0[4 * gi + 3] = __builtin_amdgcn_exp2f(p0[4 * gi + 3] + a); a += l0[4 * gi + 3]; p0[4 * gi + 2] = __builtin_amdgcn_exp2f(p0[4 * gi + 2] + a); a += l0[4 * gi + 2];
                  p0[4 * gi + 1] = __builtin_amdgcn_exp2f(p0[4 * gi + 1] + a); a += l0[4 * gi + 1]; p0[4 * gi] = __builtin_amdgcn_exp2f(p0[4 * gi] + a); }
                { float a = carry + aft[4 + gi]; p1[4 * gi + 3] = __builtin_amdgcn_exp2f(p1[4 * gi + 3] + a); a += l1[4 * gi + 3]; p1[4 * gi + 2] = __builtin_amdgcn_exp2f(p1[4 * gi + 2] + a); a += l1[4 * gi + 2];
                  p1[4 * gi + 1] = __builtin_amdgcn_exp2f(p1[4 * gi + 1] + a); a += l1[4 * gi + 1]; p1[4 * gi] = __builtin_amdgcn_exp2f(p1[4 * gi] + a); } }
            carry += run;
            bf16x8 pa0, pa1, pa2, pa3; pack_p(p0, p1, pa0, pa1, pa2, pa3);
            pv_tile(o, vb0, pa0, pa1, pa2, pa3);
            if (__all(carry < -160.f)) { wdone = true; if (lane == 0) flg[wid] = 1u; }
        }
        if (jn < 0) break;
        jt = jn;
    }
    bf16_t* op = att + (size_t)(b * T_ + q0 + wid * 32) * DM + h * 128;
#pragma unroll
    for (int r = 0; r < 16; ++r) { const int row = crow(r, hi);
#pragma unroll
        for (int d0 = 0; d0 < 4; ++d0) { const float v = o[d0][r]; const float vn = __shfl_xor(v, 1);
            if ((r32 & 1) == 0) *(unsigned*)(op + (size_t)row * DM + d0 * 32 + r32) = cvtpk(v, vn); } }
    __syncthreads();
}
}

DI void tconv_tile(const float* src, int ld, int nvalid, int k0, int n0, bf16_t* dst, int dld, LAS unsigned char* lds) {
    const int tid = threadIdx.x;
    constexpr int RS = 264;
    __syncthreads();
#pragma unroll
    for (int i = 0; i < 8; ++i) { const int idx = tid + 512 * i, k = idx >> 5, n4 = idx & 31;
        f32x4 v = {0.f, 0.f, 0.f, 0.f};
        if (n0 + 4 * n4 < nvalid) v = *(const f32x4*)(src + (size_t)(k0 + k) * ld + n0 + 4 * n4);
        u32x2 w = {cvtpk(v[0], v[1]), cvtpk(v[2], v[3])};
        *(LAS u32x2*)(lds + k * RS + n4 * 8) = w; }
    __syncthreads();
    const int n = tid & 127, kq = tid >> 7;
#pragma unroll
    for (int j = 0; j < 4; ++j) { unsigned short e[8];
#pragma unroll
        for (int q = 0; q < 8; ++q) e[q] = *(const LAS unsigned short*)(lds + (kq * 32 + j * 8 + q) * RS + n * 2);
        u32x4 w = {(unsigned)e[0] | ((unsigned)e[1] << 16), (unsigned)e[2] | ((unsigned)e[3] << 16), (unsigned)e[4] | ((unsigned)e[5] << 16), (unsigned)e[6] | ((unsigned)e[7] << 16)};
        *(u32x4*)(dst + (size_t)n * dld + k0 + kq * 32 + j * 8) = w; }
}
DI void norm_row(const float* xrow, const float* g, bf16_t* hrow, int lane) {
    f32x4 v[8]; float ss = 0.f;
#pragma unroll
    for (int i = 0; i < 8; ++i) { v[i] = *(const f32x4*)(xrow + i * 256 + lane * 4); ss += (v[i][0] * v[i][0] + v[i][1] * v[i][1]) + (v[i][2] * v[i][2] + v[i][3] * v[i][3]); }
    ss = wave_sum(ss);
    const float rs = __builtin_amdgcn_rsqf(ss * (1.0f / 2048.0f) + 1e-6f);
#pragma unroll
    for (int i = 0; i < 8; ++i) { const f32x4 gg = *(const f32x4*)(g + i * 256 + lane * 4);
        u32x2 w = {cvtpk(v[i][0] * rs * gg[0], v[i][1] * rs * gg[1]), cvtpk(v[i][2] * rs * gg[2], v[i][3] * rs * gg[3])};
        *(u32x2*)(hrow + i * 256 + lane * 4) = w; }
}

struct Args { const float* in[18]; float* out; unsigned char* ws; int ph_lo, ph_hi; };

DI void phase_prologue(const Args& a, LAS unsigned char* lds) {
    const int tid = threadIdx.x, wid = tid >> 6, lane = tid & 63, G = gridDim.x, bx = blockIdx.x;
    unsigned char* ws = a.ws;
    constexpr int J0 = 672, J1 = J0 + 256, J2 = J1 + 768, J3 = J2 + 256, J4 = J3 + 4096, J5 = J4 + 4096, J6 = J5 + 4096, J7 = J6 + 64, J8 = J7 + 2;
    for (int job = bx; job < J8; job += G) {
        const float* src; int ld, nvalid, K, kt, n0; bf16_t* dst;
        if (job < J0) { const int i = job; kt = i % 16; n0 = (i / 16) * 128; src = a.in[3]; ld = 5168; nvalid = 5168; K = 2048; dst = (bf16_t*)(ws + WS_WIN0) + (size_t)n0 * K; }
        else if (job < J1) { const int i = job - J0; kt = i % 16; n0 = (i / 16) * 128; src = a.in[8]; ld = 2048; nvalid = 2048; K = 2048; dst = (bf16_t*)(ws + WS_WOUT0) + (size_t)n0 * K; }
        else if (job < J2) { const int i = job - J1; kt = i % 16; n0 = (i / 16) * 128; src = a.in[9]; ld = 6144; nvalid = 6144; K = 2048; dst = (bf16_t*)(ws + WS_WIN1) + (size_t)n0 * K; }
        else if (job < J3) { const int i = job - J2; kt = i % 16; n0 = (i / 16) * 128; src = a.in[10]; ld = 2048; nvalid = 2048; K = 2048; dst = (bf16_t*)(ws + WS_WOUT1) + (size_t)n0 * K; }
        else if (job < J5) { const bool up = job >= J4; const int i = job - (up ? J4 : J3); const int mat = i >> 6, r = i & 63; kt = r % 16; n0 = (r / 16) * 128;
            src = a.in[up ? 16 : 15] + (size_t)mat * 2048 * 512; ld = 512; nvalid = 512; K = 2048;
            dst = (bf16_t*)(ws + WS_W1) + ((size_t)mat * 1024 + (n0 / 128) * 256 + (up ? 128 : 0)) * K; }
        else if (job < J6) { const int i = job - J5; const int mat = i >> 6, r = i & 63; kt = r % 4; n0 = (r / 4) * 128;
            src = a.in[17] + (size_t)mat * 512 * 2048; ld = 2048; nvalid = 2048; K = 512; dst = (bf16_t*)(ws + WS_W2) + ((size_t)mat * 2048 + n0) * K; }
        else if (job < J7) { const int i = job - J6; const int kv = i >> 5; kt = i & 31; n0 = 0; src = a.in[6] + (size_t)kv * 4096 * 128; ld = 128; nvalid = 128; K = 4096; dst = (bf16_t*)(ws + WS_CW1) + (size_t)kv * 128 * K; }
        else { const int kv = job - J7; kt = 0; n0 = 0; src = a.in[7] + (size_t)kv * 128 * 128; ld = 128; nvalid = 128; K = 128; dst = (bf16_t*)(ws + WS_CW2) + (size_t)kv * 128 * K; }
        tconv_tile(src, ld, nvalid, kt * 128, n0, dst, K, lds);
    }
    for (int i = bx * 512 + tid; i < 2 * 256 * 2048; i += G * 512) { const int k = i & 2047, r = (i >> 11) & 255, L = i >> 19;
        float v = 0.f; if (r < 4) v = a.in[11][((size_t)L * 2048 + k) * 4 + r]; else if (r < 36) v = a.in[13][((size_t)L * 2048 + k) * 32 + (r - 4)];
        ((bf16_t*)(ws + WS_WR))[i] = (bf16_t)(cvtpk(v, 0.f) & 0xffffu); }
    for (int o = bx * 8 + wid; o < 256; o += G * 8) { const int kv = o >> 7, f = o & 127; float s = 0.f;
        for (int kk = lane; kk < 4096; kk += 64) s += a.in[5][kv * 4096 + kk] * a.in[6][((size_t)kv * 4096 + kk) * 128 + f];
        s = wave_sum(s); if (lane == 0) ((float*)(ws + WS_BIAS1))[o] = s; }
    for (int row = bx * 8 + wid; row < NTOK; row += G * 8) norm_row(a.in[0] + (size_t)row * DM, a.in[1], (bf16_t*)(ws + WS_H) + (size_t)row * DM, lane);
}

DI void phase_norm(const float* x, const float* g, bf16_t* h) {
    const int tid = threadIdx.x, wid = tid >> 6, lane = tid & 63;
    for (int row = blockIdx.x * 8 + wid; row < NTOK; row += gridDim.x * 8) norm_row(x + (size_t)row * DM, g, h + (size_t)row * DM, lane);
}

DI void cmp_item(LAS unsigned char* lds, int item, const bf16_t* proj, const bf16_t* cw1t, const bf16_t* cw2t, const float* bias1, const float* gain1, bf16_t* kcmp, bf16_t* vcmp) {
    const int tid = threadIdx.x, wid = __builtin_amdgcn_readfirstlane(tid >> 6), lane = tid & 63, fr = lane & 15, fq = lane >> 4;
    const int kv = item >> 7, rt = item & 127, bg = rt >> 4, n0 = (rt & 15) * 32, b = bg >> 2, g = bg & 3;
    const bf16_t* abase = proj + (size_t)b * T_ * LDP0 + C_KC + kv * 512 + g * 128 + fq * 8;
    const bf16_t* bbase = cw1t + (size_t)(kv * 128 + wid * 16 + fr) * 4096 + fq * 8;
    f32x4 acc[2] = {{0.f, 0.f, 0.f, 0.f}, {0.f, 0.f, 0.f, 0.f}};
    const int tk0 = 16 * (n0 + fr), tk1 = 16 * (n0 + 16 + fr);
#pragma unroll 4
    for (int ks = 0; ks < 128; ++ks) { const int l = ks >> 2, dp = (ks & 3) * 32;
        int ta = tk0 + l, tb = tk1 + l; ta = ta < T_ ? ta : T_ - 1; tb = tb < T_ ? tb : T_ - 1;
        const bf16x8 a0 = *(const bf16x8*)(abase + (size_t)ta * LDP0 + dp), a1 = *(const bf16x8*)(abase + (size_t)tb * LDP0 + dp);
        const bf16x8 bb = *(const bf16x8*)(bbase + ks * 32);
        acc[0] = __builtin_amdgcn_mfma_f32_16x16x32_bf16(a0, bb, acc[0], 0, 0, 0);
        acc[1] = __builtin_amdgcn_mfma_f32_16x16x32_bf16(a1, bb, acc[1], 0, 0, 0); }
    constexpr int HP = 272;
    const float b1 = bias1[kv * 128 + wid * 16 + fr];
    __syncthreads();
#pragma unroll
    for (int rb = 0; rb < 2; ++rb)
#pragma unroll
        for (int j = 0; j < 4; ++j) { const float x = acc[rb][j] + b1; const float u = 0.7978845608028654f * (x + 0.044715f * x * x * x);
            const float hv = x * __builtin_amdgcn_rcpf(1.0f + __builtin_amdgcn_exp2f(-2.0f * LOG2E * u));
            *(LAS unsigned short*)(lds + (rb * 16 + fq * 4 + j) * HP + (wid * 16 + fr) * 2) = (unsigned short)(cvtpk(hv, 0.f) & 0xffffu); }
    __syncthreads();
    f32x4 ac2[2] = {{0.f, 0.f, 0.f, 0.f}, {0.f, 0.f, 0.f, 0.f}};
    const bf16_t* b2base = cw2t + (size_t)(kv * 128 + wid * 16 + fr) * 128 + fq * 8;
#pragma unroll
    for (int ks = 0; ks < 4; ++ks) { const bf16x8 bb = *(const bf16x8*)(b2base + ks * 32);
#pragma unroll
        for (int rb = 0; rb < 2; ++rb) { const bf16x8 aa = *(const LAS bf16x8*)(lds + (rb * 16 + fr) * HP + (ks * 32 + fq * 8) * 2);
            ac2[rb] = __builtin_amdgcn_mfma_f32_16x16x32_bf16(aa, bb, ac2[rb], 0, 0, 0); } }
    LAS float* part = (LAS float*)(lds + 32 * HP);
    float scl[2][4];
    if (kv == 0) {
#pragma unroll
        for (int rb = 0; rb < 2; ++rb)
#pragma unroll
            for (int j = 0; j < 4; ++j) { float s = ac2[rb][j] * ac2[rb][j]; s += __shfl_xor(s, 1); s += __shfl_xor(s, 2); s += __shfl_xor(s, 4); s += __shfl_xor(s, 8);
                if (fr == 0) part[wid * 32 + rb * 16 + fq * 4 + j] = s; }
        __syncthreads();
        const float gn = gain1[wid * 16 + fr];
#pragma unroll
        for (int rb = 0; rb < 2; ++rb)
#pragma unroll
            for (int j = 0; j < 4; ++j) { float s = 0.f;
#pragma unroll
                for (int w = 0; w < 8; ++w) s += part[w * 32 + rb * 16 + fq * 4 + j];
                scl[rb][j] = __builtin_amdgcn_rsqf(s * (1.0f / 128.0f) + 1e-6f) * gn; }
    } else {
#pragma unroll
        for (int rb = 0; rb < 2; ++rb)
#pragma unroll
            for (int j = 0; j < 4; ++j) scl[rb][j] = 1.0f;
    }
    bf16_t* dst = (kv == 0 ? kcmp : vcmp) + (size_t)(bg * 512 + n0) * 128 + wid * 16 + fr;
#pragma unroll
    for (int rb = 0; rb < 2; ++rb)
#pragma unroll
        for (int j = 0; j < 4; ++j) dst[(size_t)(rb * 16 + fq * 4 + j) * 128] = (bf16_t)(cvtpk(ac2[rb][j] * scl[rb][j], 0.f) & 0xffffu);
    __syncthreads();
}
DI void knorm_phase(bf16_t* proj, const float* qk_gain) {
    const int gid = blockIdx.x * 512 + threadIdx.x, sub = gid & 15;
    for (int rowid = gid >> 4; rowid < NTOK * 8; rowid += gridDim.x * 32) { const int tok = rowid >> 3, selw = (rowid >> 2) & 1, g = rowid & 3;
        bf16_t* p = proj + (size_t)tok * LDP0 + (selw ? C_KW : C_KS) + g * 128 + sub * 8;
        const u32x4 raw = *(const u32x4*)p; float f[8]; float ss = 0.f;
#pragma unroll
        for (int e = 0; e < 4; ++e) { f[2 * e] = bflo(raw[e]); f[2 * e + 1] = bfhi(raw[e]); ss += f[2 * e] * f[2 * e] + f[2 * e + 1] * f[2 * e + 1]; }
        ss += __shfl_xor(ss, 1); ss += __shfl_xor(ss, 2); ss += __shfl_xor(ss, 4); ss += __shfl_xor(ss, 8);
        const float rs = __builtin_amdgcn_rsqf(ss * (1.0f / 128.0f) + 1e-6f);
        const float* gp = qk_gain + (selw ? 3 : 2) * 128 + sub * 8; const f32x4 g0 = *(const f32x4*)gp, g1 = *(const f32x4*)(gp + 4);
        u32x4 w = {cvtpk(f[0] * rs * g0[0], f[1] * rs * g0[1]), cvtpk(f[2] * rs * g0[2], f[3] * rs * g0[3]), cvtpk(f[4] * rs * g1[0], f[5] * rs * g1[1]), cvtpk(f[6] * rs * g1[2], f[7] * rs * g1[3])};
        *(u32x4*)p = w; }
}

DI void route_phase(LAS unsigned char* lds, const float* logits, const float* bgp, const float* brp, unsigned* cnt, int* rows, float* tokinfo) {
    const int tid = threadIdx.x;
    LAS unsigned* hist = (LAS unsigned*)lds; LAS unsigned* base = hist + 32;
    for (int chunk = blockIdx.x; chunk < NTOK / 64; chunk += gridDim.x) {
        __syncthreads();
        if (tid < 32) hist[tid] = 0u;
        __syncthreads();
        int e1 = 0, e2 = 0; float w1 = 0.f, w2 = 0.f; unsigned p1 = 0, p2 = 0; const int tok = chunk * 64 + tid;
        if (tid < 64) {
            const float* lg = logits + (size_t)tok * 256;
            float gl[4]; float gm = -3.0e38f; int gs = 0;
#pragma unroll
            for (int i = 0; i < 4; ++i) { gl[i] = lg[i] + bgp[i]; if (gl[i] > gm) { gm = gl[i]; gs = i; } }
            float gsum = 0.f;
#pragma unroll
            for (int i = 0; i < 4; ++i) gsum += __expf(gl[i] - gm);
            const float pg = 1.0f / gsum;
            float el[8]; float m1 = -3.0e38f; int s1 = 0;
#pragma unroll
            for (int i = 0; i < 8; ++i) { el[i] = lg[4 + gs * 8 + i] + brp[gs * 8 + i]; if (el[i] > m1) { m1 = el[i]; s1 = i; } }
            float m2 = -3.0e38f; int s2 = 0;
#pragma unroll
            for (int i = 0; i < 8; ++i) if (i != s1 && el[i] > m2) { m2 = el[i]; s2 = i; }
            const float x2 = __expf(m2 - m1), den = 1.0f / (1.0f + x2);
            w1 = pg * den; w2 = pg * x2 * den; e1 = gs * 8 + s1; e2 = gs * 8 + s2;
            p1 = __hip_atomic_fetch_add(hist + e1, 1u, __ATOMIC_RELAXED, __HIP_MEMORY_SCOPE_WORKGROUP);
            p2 = __hip_atomic_fetch_add(hist + e2, 1u, __ATOMIC_RELAXED, __HIP_MEMORY_SCOPE_WORKGROUP);
        }
        __syncthreads();
        if (tid < 32) { const unsigned hcount = hist[tid]; base[tid] = hcount ? __hip_atomic_fetch_add(cnt + tid, hcount, __ATOMIC_RELAXED, __HIP_MEMORY_SCOPE_AGENT) : 0u; }
        __syncthreads();
        if (tid < 64) { p1 += base[e1]; p2 += base[e2];
            rows[e1 * 16384 + (int)p1] = tok; rows[e2 * 16384 + (int)p2] = tok;
            float* ti = tokinfo + (size_t)tok * 8; ti[0] = __int_as_float(e1); ti[1] = __int_as_float((int)p1); ti[2] = w1; ti[3] = __int_as_float(e2); ti[4] = __int_as_float((int)p2); ti[5] = w2; }
    }
}
DI int moe_tables(LAS unsigned char* misc, const unsigned* cnt) {
    const int tid = threadIdx.x; LAS int* w = (LAS int*)misc;
    __syncthreads();
    if (tid < 32) w[16 + tid] = (int)cnt[tid];
    __syncthreads();
    if (tid == 0) { int acc = 0; for (int e = 0; e < 32; ++e) { w[48 + e] = acc; acc += (w[16 + e] + 255) >> 8; } w[80] = acc; }
    __syncthreads();
    const int ntot = w[80];
    for (int rt = tid; rt < ntot; rt += 512) { int e = 0;
        for (int k = 0; k < 32; ++k) if (w[48 + k] <= rt && rt < w[48 + k + 1]) e = k;
        const int loc = (rt - w[48 + e]) * 256; int nv = w[16 + e] - loc; nv = nv > 256 ? 256 : nv;
        w[128 + rt * 4] = e; w[128 + rt * 4 + 1] = e * 16384 + loc; w[128 + rt * 4 + 2] = nv; w[128 + rt * 4 + 3] = 0; }
    __syncthreads();
    return ntot;
}
DI void combine_phase(LAS unsigned char* misc, const float* tokinfo, const bf16_t* Y, float* xr, float* out, const float* gnext, bf16_t* h) {
    const int tid = threadIdx.x, wid = tid >> 6, lane = tid & 63; const LAS int* w = (const LAS int*)misc;
    for (int tok = blockIdx.x * 8 + wid; tok < NTOK; tok += gridDim.x * 8) {
        const float* ti = tokinfo + (size_t)tok * 8;
        const int e1 = __float_as_int(ti[0]), p1 = __float_as_int(ti[1]), e2 = __float_as_int(ti[3]), p2 = __float_as_int(ti[4]); const float w1 = ti[2], w2 = ti[5];
        const bf16_t* y1 = Y + ((size_t)w[48 + e1] * 256 + p1) * DM; const bf16_t* y2 = Y + ((size_t)w[48 + e2] * 256 + p2) * DM;
        float* xp = xr + (size_t)tok * DM; f32x4 v[8]; float ss = 0.f;
#pragma unroll
        for (int i = 0; i < 8; ++i) { const int col = i * 256 + lane * 4; const f32x4 x = *(const f32x4*)(xp + col); const u32x2 a = *(const u32x2*)(y1 + col), bq = *(const u32x2*)(y2 + col);
            v[i][0] = x[0] + (w1 * bflo(a[0]) + w2 * bflo(bq[0])); v[i][1] = x[1] + (w1 * bfhi(a[0]) + w2 * bfhi(bq[0]));
            v[i][2] = x[2] + (w1 * bflo(a[1]) + w2 * bflo(bq[1])); v[i][3] = x[3] + (w1 * bfhi(a[1]) + w2 * bfhi(bq[1]));
            ss += (v[i][0] * v[i][0] + v[i][1] * v[i][1]) + (v[i][2] * v[i][2] + v[i][3] * v[i][3]); }
        if (out) {
#pragma unroll
            for (int i = 0; i < 8; ++i) *(f32x4*)(out + (size_t)tok * DM + i * 256 + lane * 4) = v[i];
        } else {
            ss = wave_sum(ss); const float rs = __builtin_amdgcn_rsqf(ss * (1.0f / 2048.0f) + 1e-6f);
#pragma unroll
            for (int i = 0; i < 8; ++i) { const int col = i * 256 + lane * 4; *(f32x4*)(xp + col) = v[i]; const f32x4 gg = *(const f32x4*)(gnext + col);
                u32x2 wv = {cvtpk(v[i][0] * rs * gg[0], v[i][1] * rs * gg[1]), cvtpk(v[i][2] * rs * gg[2], v[i][3] * rs * gg[3])};
                *(u32x2*)(h + (size_t)tok * DM + col) = wv; }
        }
    }
}

constexpr int NPHASE = 20;
__global__ void __launch_bounds__(512, 2) fwd(Args a) {
    extern __shared__ __attribute__((aligned(16))) unsigned char shm[];
    LAS unsigned char* lds = (LAS unsigned char*)shm;
    LAS unsigned char* misc = lds + LDS_MISC;
    const int tid = threadIdx.x, G = gridDim.x, bx = blockIdx.x;
    unsigned char* ws = a.ws;
    if (tid < 4) ((LAS unsigned*)misc)[tid] = 0u;
    __syncthreads();
    const int lo = a.ph_lo, hi = a.ph_hi;
    XcdBarrier bar; bar.bar = (unsigned*)(ws + WS_BAR); bar.x = 0; bar.st = nullptr;
    if (hi - lo > 1) bar = xcd_barrier_post((unsigned*)(ws + WS_BAR), (volatile LAS unsigned*)misc);
#ifndef PHMASK
#define PHMASK 0xFFFFFu
#endif
#define IN(k) (((PHMASK >> (k)) & 1u) && lo <= (k) && (k) < hi)
#define SEAM(k) do { if (IN(k) && IN((k) + 1)) xcd_barrier(bar); } while (0)
    bf16_t* H = (bf16_t*)(ws + WS_H); bf16_t* PROJ = (bf16_t*)(ws + WS_PROJ); bf16_t* ATT = (bf16_t*)(ws + WS_ATT); float* XR = (float*)(ws + WS_XR);
    bf16_t* KCMP = (bf16_t*)(ws + WS_KCMP); bf16_t* VCMP = (bf16_t*)(ws + WS_VCMP);
    float* LOGITS = (float*)(ws + WS_PROJ); bf16_t* Y = (bf16_t*)(ws + WS_PROJ); bf16_t* ACT = (bf16_t*)(ws + WS_ATT);
    int* ROWS = (int*)(ws + WS_ROWS); float* TOK = (float*)(ws + WS_TOK);

    if (IN(0)) { phase_prologue(a, lds); } SEAM(0);
    if (IN(1)) { pg8::Gemm g{H, (const bf16_t*)(ws + WS_WIN0), DM}; pg8::StaticOrder S; S.init(NTOK, LDP0, G, bx); pg8::EpiBf16 E{PROJ, LDP0};
        pg8::gemm_phase(lds, g, S, E); } SEAM(1);
    if (IN(2)) { for (int it = bx; it < 256; it += G) cmp_item(lds, it, PROJ, (const bf16_t*)(ws + WS_CW1), (const bf16_t*)(ws + WS_CW2), (const float*)(ws + WS_BIAS1), a.in[4] + 128, KCMP, VCMP);
        knorm_phase(PROJ, a.in[4]); } SEAM(2);
    if (IN(3)) {
        { int s = 0; for (int it = bx; it < 1024; it += G, ++s) at::nsa_cmp_item((LAS char*)lds, it, s & 7, PROJ, KCMP, VCMP, a.in[4], ATT); }
        { int s = 0; for (int it = bx; it < 1024; it += G, ++s) at::nsa_slc_item((LAS char*)lds, it, s & 7, PROJ, a.in[4], ATT); }
        for (int it = bx; it < 1024; it += G) at::nsa_win_item((LAS char*)lds, it, PROJ, a.in[4], ATT);
    } SEAM(3);
    if (IN(4)) { pg8::Gemm g{ATT, (const bf16_t*)(ws + WS_WOUT0), DM}; pg8::StaticOrder S; S.init(NTOK, DM, G, bx); pg8::EpiF32 E{a.in[0], XR, DM};
        pg8::gemm_phase(lds, g, S, E); } SEAM(4);
#define MOE_LAYER(L, p0) do { \
        unsigned* cnt = (unsigned*)(ws + WS_CNT) + 32 * (L); \
        if (IN((p0))) { phase_norm(XR, a.in[2] + (L) * DM, H); } SEAM((p0)); \
        if (IN((p0) + 1)) { pg8::Gemm g{H, (const bf16_t*)(ws + WS_WR) + (size_t)(L) * 256 * DM, DM}; pg8::StaticOrder S; S.init(NTOK, 256, G, bx); pg8::EpiF32 E{nullptr, LOGITS, 256}; \
            pg8::gemm_phase(lds, g, S, E); } SEAM((p0) + 1); \
        if (IN((p0) + 2)) { route_phase(lds, LOGITS, a.in[12] + (L) * 4, a.in[14] + (L) * 32, cnt, ROWS, TOK); } SEAM((p0) + 2); \
        if (IN((p0) + 3)) { const int ntot = moe_tables(misc, cnt); \
            pg8::Gemm g{H, (const bf16_t*)(ws + WS_W1) + (size_t)(L) * 32 * 1024 * DM, DM}; \
            pg8::MoeOrder<true> S{ntot * 4, 4, G, bx, (const LAS int*)misc + 128, ROWS}; pg8::EpiSwiglu E{ACT}; \
            pg8::gemm_phase(lds, g, S, E); } SEAM((p0) + 3); \
        if (IN((p0) + 4)) { const int ntot = moe_tables(misc, cnt); \
            pg8::Gemm g{ACT, (const bf16_t*)(ws + WS_W2) + (size_t)(L) * 32 * DM * 512, DEXP}; \
            pg8::MoeOrder<false> S{ntot * 8, 8, G, bx, (const LAS int*)misc + 128, ROWS}; pg8::EpiBf16 E{Y, DM}; \
            pg8::gemm_phase(lds, g, S, E); } SEAM((p0) + 4); \
        if (IN((p0) + 5)) { (void)moe_tables(misc, cnt); \
            combine_phase(misc, TOK, Y, XR, (L) == 1 ? a.out : nullptr, a.in[1] + DM, H); } SEAM((p0) + 5); } while (0)
    MOE_LAYER(0, 5);
    if (IN(11)) { pg8::Gemm g{H, (const bf16_t*)(ws + WS_WIN1), DM}; pg8::StaticOrder S; S.init(NTOK, LDP1, G, bx); pg8::EpiBf16 E{PROJ, LDP1};
        pg8::gemm_phase(lds, g, S, E); } SEAM(11);
    if (IN(12)) { for (int it = bx; it < 1024; it += G) at::sb_item((LAS char*)lds, it, PROJ, ATT); } SEAM(12);
    if (IN(13)) { pg8::Gemm g{ATT, (const bf16_t*)(ws + WS_WOUT1), DM}; pg8::StaticOrder S; S.init(NTOK, DM, G, bx); pg8::EpiF32 E{XR, XR, DM};
        pg8::gemm_phase(lds, g, S, E); } SEAM(13);
    MOE_LAYER(1, 14);
#undef MOE_LAYER
#undef IN
#undef SEAM
}

extern "C" void kernel_launch(void* const* d_in, const int* in_sizes, int n_in, void* d_out, int out_size, void* d_ws, size_t ws_size, hipStream_t stream) {
    static int grid = 0;
    if (grid == 0) {
        if (n_in != 18 || out_size != NTOK * DM || ws_size < WS_END) { fprintf(stderr, "kernel_launch: unexpected shapes (n_in %d out %d ws %zu need %zu)\n", n_in, out_size, ws_size, (size_t)WS_END); grid = -1; return; }
        int dev = 0, cus = 0, per_cu = 0;
        if (hipGetDevice(&dev) != hipSuccess || hipDeviceGetAttribute(&cus, hipDeviceAttributeMultiprocessorCount, dev) != hipSuccess) { grid = -1; return; }
        if (hipFuncSetAttribute((const void*)fwd, hipFuncAttributeMaxDynamicSharedMemorySize, LDS_BYTES) != hipSuccess) { fprintf(stderr, "kernel_launch: hipFuncSetAttribute failed\n"); grid = -1; return; }
        if (hipOccupancyMaxActiveBlocksPerMultiprocessor(&per_cu, (const void*)fwd, 512, LDS_BYTES) != hipSuccess || per_cu < 1) { fprintf(stderr, "kernel_launch: occupancy query says %d\n", per_cu); }
        (void)hipGetLastError();
        grid = cus;
    }
    if (grid < 0) return;
    (void)hipMemsetAsync((char*)d_ws, 0, WS_ZERO_BYTES, stream);
    Args a{};
    for (int i = 0; i < 18; ++i) a.in[i] = (const float*)d_in[i];
    a.out = (float*)d_out; a.ws = (unsigned char*)d_ws;
#ifndef ONE_LAUNCH
#define ONE_LAUNCH 0
#endif
    if (ONE_LAUNCH) { a.ph_lo = 0; a.ph_hi = NPHASE; hipLaunchKernelGGL(fwd, dim3(grid), dim3(512), LDS_BYTES, stream, a); }
    else for (int p = 0; p < NPHASE; ++p) { a.ph_lo = p; a.ph_hi = p + 1; hipLaunchKernelGGL(fwd, dim3(grid), dim3(512), LDS_BYTES, stream, a); }
}
```

```cpp
#include <hip/hip_runtime.h>
#include <stdint.h>
#include <stdio.h>

#define LAS __attribute__((address_space(3)))
#define DI __device__ __forceinline__
typedef unsigned short bf16_t;
typedef short bf16x8 __attribute__((ext_vector_type(8)));
typedef short s16x4 __attribute__((ext_vector_type(4)));
typedef float f32x4 __attribute__((ext_vector_type(4)));
typedef float f32x2 __attribute__((ext_vector_type(2)));
typedef float f32x16 __attribute__((ext_vector_type(16)));
typedef unsigned u32x4 __attribute__((ext_vector_type(4)));
typedef unsigned u32x2 __attribute__((ext_vector_type(2)));

constexpr int T_ = 8192, B_ = 2, NTOK = B_ * T_, DM = 2048, HD = 128, NH = 16, NKV = 4;
constexpr int LDP0 = 5376;
constexpr int C_Q = 0, C_KC = 2048, C_VC = 2560, C_KS = 3072, C_VS = 3584, C_KW = 4096, C_VW = 4608, C_GT = 5120;
constexpr int LDP1 = 6144;
constexpr int NEXP = 32, DEXP = 512;
constexpr int MAXTILES = 160;
constexpr float LOG2E = 1.4426950408889634f;
constexpr float QSCALE = 0.08838834764831845f;

constexpr size_t WS_BAR   = 0;
constexpr size_t WS_CNT   = 16384;
constexpr size_t WS_ZERO_BYTES = 32768;
constexpr size_t WS_BIAS1 = 32768;
constexpr size_t WS_WIN0  = 1u << 20;
constexpr size_t WS_WOUT0 = WS_WIN0 + (size_t)LDP0 * DM * 2;
constexpr size_t WS_WIN1  = WS_WOUT0 + (size_t)DM * DM * 2;
constexpr size_t WS_WOUT1 = WS_WIN1 + (size_t)LDP1 * DM * 2;
constexpr size_t WS_WR    = WS_WOUT1 + (size_t)DM * DM * 2;
constexpr size_t WS_W1    = WS_WR + (size_t)2 * 256 * DM * 2;
constexpr size_t WS_W2    = WS_W1 + (size_t)2 * 32 * 1024 * DM * 2;
constexpr size_t WS_CW1   = WS_W2 + (size_t)2 * 32 * DM * 512 * 2;
constexpr size_t WS_CW2   = WS_CW1 + (size_t)2 * 128 * 4096 * 2;
constexpr size_t WS_H     = WS_CW2 + (size_t)2 * 128 * 128 * 2;
constexpr size_t WS_PROJ  = WS_H + (size_t)NTOK * DM * 2;
constexpr size_t WS_ATT   = WS_PROJ + (size_t)NTOK * LDP1 * 2;
constexpr size_t WS_XR    = WS_ATT + (size_t)NTOK * DM * 2;
constexpr size_t WS_KCMP  = WS_XR + (size_t)NTOK * DM * 4;
constexpr size_t WS_VCMP  = WS_KCMP + (size_t)2 * 4 * 512 * 128 * 2;
constexpr size_t WS_ROWS  = WS_VCMP + (size_t)2 * 4 * 512 * 128 * 2;
constexpr size_t WS_TOK   = WS_ROWS + (size_t)32 * 16384 * 4;
constexpr size_t WS_END   = WS_TOK + (size_t)NTOK * 32;

constexpr int LDS_STAGE = 131072;
constexpr int LDS_MISC  = 131072;
constexpr int LDS_BYTES = 131072 + 4096;

DI unsigned cvtpk(float lo, float hi) { unsigned r; asm volatile("v_cvt_pk_bf16_f32 %0, %1, %2" : "=v"(r) : "v"(lo), "v"(hi)); return r; }
DI float bflo(unsigned w) { return __uint_as_float(w << 16); }
DI float bfhi(unsigned w) { return __uint_as_float(w & 0xffff0000u); }
DI float wave_sum(float v) { for (int o = 32; o >= 1; o >>= 1) v += __shfl_xor(v, o); return v; }
DI bf16x8 pack8(f32x4 a, f32x4 b) { u32x4 w = {cvtpk(a[0], a[1]), cvtpk(a[2], a[3]), cvtpk(b[0], b[1]), cvtpk(b[2], b[3])}; return __builtin_bit_cast(bf16x8, w); }

#define XB_TMO      128
#define XB_XCNT(j)  (256  + 64 * (j))
#define XB_XSUB(j)  (1280 + 64 * (j))
#define XB_XGEN(j)  (2304 + 64 * (j))
#define XB_TOP      3328
#define XB_TOPGEN   3392
#define XCD_BAR_WORDS 3456
#define XB_SPIN_CAP (1u << 18)
__device__ __forceinline__ unsigned xb_ld(unsigned* p)              { return __hip_atomic_load(p, __ATOMIC_RELAXED, __HIP_MEMORY_SCOPE_AGENT); }
__device__ __forceinline__ unsigned xb_add(unsigned* p, unsigned v) { return __hip_atomic_fetch_add(p, v, __ATOMIC_RELAXED, __HIP_MEMORY_SCOPE_AGENT); }
__device__ __forceinline__ unsigned xb_xcc_id() { return (unsigned)__builtin_amdgcn_s_getreg((3 << 11) | 20) & 0xFu; }
#define XB_SPIN(cond, bar) do { unsigned _sp = 0; while (cond) { __builtin_amdgcn_s_sleep(1); \
    if ((++_sp & 255u) == 0u) { if (xb_ld(&(bar)[XB_TMO])) break; if (_sp > XB_SPIN_CAP) { atomicAdd(&(bar)[XB_TMO], 1u); break; } } } } while (0)
struct XcdBarrier { unsigned* bar; unsigned x; volatile LAS unsigned* st; };
__device__ __forceinline__ XcdBarrier xcd_barrier_post(unsigned* bar, volatile LAS unsigned* st) {
    XcdBarrier b; b.bar = bar; b.x = xb_xcc_id(); b.st = st;
    if (threadIdx.x == 0) (void)xb_add(&bar[XB_XCNT(b.x)], 1u);
    return b;
}
__device__ __forceinline__ void xcd_barrier_complete(unsigned* bar, unsigned x, unsigned& nloc, unsigned& nx) {
    const unsigned G = gridDim.x * gridDim.y * gridDim.z;
    unsigned sum, cnt, mine, sp = 0u;
    for (;;) {
        sum = 0u; cnt = 0u; mine = 0u;
#pragma unroll
        for (unsigned j = 0; j < 16; ++j) { const unsigned c = xb_ld(&bar[XB_XCNT(j)]); sum += c; cnt += (c > 0u) ? 1u : 0u; mine = (j == x) ? c : mine; }
        if (sum == G) break;
        __builtin_amdgcn_s_sleep(1);
        if ((++sp & 255u) == 0u) { if (xb_ld(&bar[XB_TMO])) break; if (sp > XB_SPIN_CAP) { atomicAdd(&bar[XB_TMO], 1u); break; } }
    }
    nloc = mine > 0u ? mine : 1u; nx = cnt > 0u ? cnt : 1u;
}
__device__ __forceinline__ void xcd_barrier(const XcdBarrier& b) {
    asm volatile("s_waitcnt vmcnt(0)" ::: "memory");
    __syncthreads();
    if (threadIdx.x == 0) {
        unsigned* bar = b.bar;
        __builtin_amdgcn_s_waitcnt(0);
        unsigned nloc = b.st[0], nx = b.st[1];
        if (nloc == 0u) { xcd_barrier_complete(bar, b.x, nloc, nx); b.st[0] = nloc; b.st[1] = nx; }
        const unsigned old = xb_add(&bar[XB_XSUB(b.x)], 1u);
        const unsigned gen = old / nloc;
        if (old + 1u == (gen + 1u) * nloc) {
            __builtin_amdgcn_fence(__ATOMIC_RELEASE, "agent");
            asm volatile("s_waitcnt vmcnt(0)" ::: "memory");
            const unsigned og = xb_add(&bar[XB_TOP], 1u);
            const unsigned tg = og / nx;
            if (og + 1u == (tg + 1u) * nx) xb_add(&bar[XB_TOPGEN], 1u);
            else XB_SPIN(xb_ld(&bar[XB_TOPGEN]) == tg, bar);
            __builtin_amdgcn_fence(__ATOMIC_ACQUIRE, "agent");
            xb_add(&bar[XB_XGEN(b.x)], 1u);
            asm volatile("s_waitcnt vmcnt(0)" ::: "memory");
        } else {
            XB_SPIN(xb_ld(&bar[XB_XGEN(b.x)]) == gen, bar);
            __builtin_amdgcn_fence(__ATOMIC_ACQUIRE, "agent");
            asm volatile("s_waitcnt vmcnt(0)" ::: "memory");
        }
    }
    __syncthreads();
}

namespace pg8 {
constexpr int BM = 256, BK = 64, HALF = 128, HTB = HALF * BK * 2, STAGE_BYTES = 8 * HTB, NXCD = 8, WGM = 8;
DI int lds_byte(int r, int c) { const int st = (r >> 4) * 2 + (c >> 5), rr = r & 15, cc = c & 31, ob = rr * 64 + cc * 2; return st * 1024 + (ob ^ (((ob >> 9) & 1) << 5)); }
DI void stage_rc(int b, int& R, int& C) { const int st = b / 1024, sb = b % 1024, swz = sb ^ (((sb >> 9) & 1) << 5); R = (st >> 1) * 16 + swz / 64; C = (st & 1) * 32 + (swz % 64) / 2; }
DI int perm32(int rho) { const int n = rho >> 4, i = rho & 15; return 8 * (i >> 2) + 4 * n + (i & 3); }
struct Unit { int pm, pn, pb; };
struct Gemm { const bf16_t* A; const bf16_t* Bt; int K; };

struct StaticOrder {
    int nM, nN, nwg, G, c;
    DI void init(int M, int N, int G_, int c_) { nM = M / BM; nN = N / BM; nwg = nM * nN; G = G_; c = c_; }
    DI bool next(int i, Unit& u) const {
        const long L = (long)i * G + c; if (L >= nwg) return false;
        int wgid = (int)L; { const int q = nwg / NXCD, r = nwg % NXCD, xcd = wgid % NXCD, off = wgid / NXCD; wgid = (xcd < r ? xcd * (q + 1) : r * (q + 1) + (xcd - r) * q) + off; }
        const int nig = WGM * nN, gid = wgid / nig, fm = gid * WGM, gsz = (nM - fm) < WGM ? (nM - fm) : WGM;
        u.pm = fm + ((wgid % nig) % gsz); u.pn = (wgid % nig) / gsz; u.pb = u.pn; return true;
    }
    DI int arow(const Unit& u, int r) const { return u.pm * BM + r; }
};
template <bool GATHER> struct MoeOrder {
    int ntot, nct, G, c; const LAS int* tinfo; const int* rows;
    DI bool next(int i, Unit& u) const {
        const int L = i * G + c; if (L >= ntot) return false;
        const int rt = L / nct, pn = L - rt * nct; u.pm = rt; u.pn = pn; u.pb = tinfo[rt * 4] * nct + pn; return true;
    }
    DI int arow(const Unit& u, int r) const {
        if constexpr (GATHER) { const int base = tinfo[u.pm * 4 + 1], nv = tinfo[u.pm * 4 + 2]; return r < nv ? rows[base + r] : 0; }
        else return u.pm * BM + r;
    }
};

struct EpiBf16 {
    static constexpr bool PERM = true;
    bf16_t* O; int ldc;
    DI void operator()(const f32x4 (&acc)[2][2][4][2], const Unit& u, int wr, int wc, int fr, int fq) const {
        const int row0 = u.pm * BM + wr * 64 + fr, col0 = u.pn * BM + wc * 32 + 8 * fq;
#pragma unroll
        for (int ai = 0; ai < 2; ++ai)
#pragma unroll
            for (int m = 0; m < 4; ++m) { bf16_t* rowp = O + (size_t)(row0 + ai * HALF + m * 16) * ldc + col0;
#pragma unroll
                for (int bj = 0; bj < 2; ++bj) { const f32x4 v0 = acc[ai][bj][m][0], v1 = acc[ai][bj][m][1];
                    u32x4 w; w.x = cvtpk(v0[0], v0[1]); w.y = cvtpk(v0[2], v0[3]); w.z = cvtpk(v1[0], v1[1]); w.w = cvtpk(v1[2], v1[3]);
                    *(u32x4*)(rowp + bj * HALF) = w; } }
    }
};
struct EpiF32 {
    static constexpr bool PERM = false;
    const float* base; float* C; int ldc;
    DI void operator()(const f32x4 (&acc)[2][2][4][2], const Unit& u, int wr, int wc, int fr, int fq) const {
        const int row0 = u.pm * BM + wr * 64 + fr, col0 = u.pn * BM + wc * 32 + 4 * fq;
#pragma unroll
        for (int ai = 0; ai < 2; ++ai)
#pragma unroll
            for (int m = 0; m < 4; ++m) { const size_t off = (size_t)(row0 + ai * HALF + m * 16) * ldc + col0;
#pragma unroll
                for (int bj = 0; bj < 2; ++bj)
#pragma unroll
                    for (int n = 0; n < 2; ++n) { f32x4 v = acc[ai][bj][m][n]; if (base) v += *(const f32x4*)(base + off + bj * HALF + n * 16);
                        *(f32x4*)(C + off + bj * HALF + n * 16) = v; } }
    }
};
struct EpiSwiglu {
    static constexpr bool PERM = true;
    bf16_t* O;
    DI void operator()(const f32x4 (&acc)[2][2][4][2], const Unit& u, int wr, int wc, int fr, int fq) const {
        const int row0 = u.pm * BM + wr * 64 + fr, col0 = u.pn * HALF + wc * 32 + 8 * fq;
#pragma unroll
        for (int ai = 0; ai < 2; ++ai)
#pragma unroll
            for (int m = 0; m < 4; ++m) { bf16_t* rowp = O + (size_t)(row0 + ai * HALF + m * 16) * DEXP + col0;
                float h[8];
#pragma unroll
                for (int n = 0; n < 2; ++n)
#pragma unroll
                    for (int j = 0; j < 4; ++j) { const float gt = acc[ai][0][m][n][j], up = acc[ai][1][m][n][j];
                        h[n * 4 + j] = gt * __builtin_amdgcn_rcpf(1.0f + __builtin_amdgcn_exp2f(-gt * LOG2E)) * up; }
                u32x4 w; w.x = cvtpk(h[0], h[1]); w.y = cvtpk(h[2], h[3]); w.z = cvtpk(h[4], h[5]); w.w = cvtpk(h[6], h[7]);
                *(u32x4*)rowp = w; }
    }
};

template <class Epi, class Sched>
DI void gemm_phase(LAS unsigned char* lds, const Gemm g, const Sched& S, const Epi& E) {
    const int tid = threadIdx.x, wid = __builtin_amdgcn_readfirstlane(tid >> 6), lane = tid & 63, wr = wid >> 2, wc = wid & 3, fr = lane & 15, fq = lane >> 4;
    const int K = g.K, nt = K / BK;
    int Ra[2]; unsigned Ca[2], voffB[2];
#pragma unroll
    for (int i = 0; i < 2; ++i) { int R, C; stage_rc(tid * 16 + i * 8192, R, C); const int Rb = Epi::PERM ? ((R & ~31) + perm32(R & 31)) : R;
        Ra[i] = R; Ca[i] = (unsigned)C * 2u; voffB[i] = (unsigned)(Rb * K + C) * 2u; }
    const unsigned rowB = (unsigned)K * 2u;
    const size_t kstep = (size_t)(BK * 2);
    const size_t hstep = (size_t)HALF * K * 2;
    const size_t tstep = 2 * hstep;
    const unsigned ldsw = (unsigned)wid * 1024u;
    const int aoff = lds_byte(wr * 64 + fr, fq * 8), boff = lds_byte(wc * 32 + fr, fq * 8);
#define PG8_SA(b, h) (((b) * 2 + (h)) * HTB)
#define PG8_SB(b, h) ((4 + (b) * 2 + (h)) * HTB)
#define PG8_STAGE(bufoff, gbase, voff) do { _Pragma("unroll") for (int _i = 0; _i < 2; ++_i) \
        __builtin_amdgcn_global_load_lds((const unsigned*)((const char*)(gbase) + (voff)[_i]), (LAS unsigned*)(lds + (bufoff) + ldsw + _i * 8192), 16, 0, 0); } while (0)
#define PG8_LDA(dst, b, h) do { _Pragma("unroll") for (int m = 0; m < 4; ++m) _Pragma("unroll") for (int k = 0; k < 2; ++k) dst[m][k] = *(const LAS bf16x8*)(lds + PG8_SA(b, h) + aoff + m * 2048 + k * 1024); } while (0)
#define PG8_LDB(dst, b, h) do { _Pragma("unroll") for (int n = 0; n < 2; ++n) _Pragma("unroll") for (int k = 0; k < 2; ++k) dst[n][k] = *(const LAS bf16x8*)(lds + PG8_SB(b, h) + boff + n * 2048 + k * 1024); } while (0)
#define PG8_MMA(ai, bj, At, Bt) do { __builtin_amdgcn_s_setprio(1); _Pragma("unroll") for (int m = 0; m < 4; ++m) _Pragma("unroll") for (int n = 0; n < 2; ++n) _Pragma("unroll") for (int k = 0; k < 2; ++k) \
        acc[ai][bj][m][n] = __builtin_amdgcn_mfma_f32_16x16x32_bf16(Bt[n][k], At[m][k], acc[ai][bj][m][n], 0, 0, 0); __builtin_amdgcn_s_setprio(0); } while (0)
#define PG8_WAIT_V(n) asm volatile("s_waitcnt vmcnt(" #n ")" ::: "memory")
#define PG8_WAIT_L(n) asm volatile("s_waitcnt lgkmcnt(" #n ")" ::: "memory")
#define PG8_BAR __builtin_amdgcn_s_barrier()
#define PG8_SCHED __builtin_amdgcn_sched_barrier(0)
#define PG8_MKVA(dst, u) do { _Pragma("unroll") for (int _h = 0; _h < 2; ++_h) _Pragma("unroll") for (int _i = 0; _i < 2; ++_i) \
        dst[_h][_i] = (unsigned)S.arow(u, _h * HALF + Ra[_i]) * rowB + Ca[_i]; } while (0)
    Unit cur, nxt; int ui = 0;
    if (!S.next(0, cur)) return;
    f32x4 acc[2][2][4][2];
#pragma unroll
    for (int a = 0; a < 2; ++a)
#pragma unroll
        for (int b = 0; b < 2; ++b)
#pragma unroll
            for (int m = 0; m < 4; ++m)
#pragma unroll
                for (int n = 0; n < 2; ++n) acc[a][b][m][n] = (f32x4){0.f, 0.f, 0.f, 0.f};
    bf16x8 At[4][2], B0[2][2], B1[2][2];
    const char* Ab = (const char*)g.A;
    unsigned va[2][2], nva[2][2];
    PG8_MKVA(va, cur);
    const char* cB = (const char*)g.Bt + (size_t)cur.pb * tstep;
    PG8_STAGE(PG8_SB(0, 0), cB, voffB); PG8_STAGE(PG8_SA(0, 0), Ab, va[0]); PG8_STAGE(PG8_SB(0, 1), cB + hstep, voffB); PG8_STAGE(PG8_SA(0, 1), Ab, va[1]);
    if (wr == 1) PG8_BAR;
    PG8_WAIT_V(4); PG8_BAR;
    PG8_STAGE(PG8_SB(1, 0), cB + kstep, voffB); PG8_STAGE(PG8_SA(1, 0), Ab + kstep, va[0]); PG8_STAGE(PG8_SB(1, 1), cB + hstep + kstep, voffB);
    PG8_WAIT_V(6); PG8_BAR;
    for (;;) {
        const bool has_next = S.next(ui + 1, nxt);
        if (has_next) { PG8_MKVA(nva, nxt); } else {
#pragma unroll
            for (int h = 0; h < 2; ++h)
#pragma unroll
                for (int i = 0; i < 2; ++i) nva[h][i] = va[h][i]; }
        const char* nB = has_next ? (const char*)g.Bt + (size_t)nxt.pb * tstep : cB;
        for (int t = 0; t < nt; t += 2) {
            const bool last = (t == nt - 2);
            const char* a1 = Ab + (size_t)(t + 1) * kstep;
            const char* a2 = last ? Ab : Ab + (size_t)(t + 2) * kstep; const char* b2 = last ? nB : cB + (size_t)(t + 2) * kstep;
            const char* a3 = a2 + kstep; const char* b3 = b2 + kstep;
            unsigned xa[2][2];
#pragma unroll
            for (int h = 0; h < 2; ++h)
#pragma unroll
                for (int i = 0; i < 2; ++i) xa[h][i] = last ? nva[h][i] : va[h][i];
            PG8_LDB(B0, 0, 0); PG8_SCHED; PG8_LDA(At, 0, 0); PG8_STAGE(PG8_SA(1, 1), a1, va[1]);
            PG8_WAIT_L(8); PG8_BAR; PG8_WAIT_L(0); PG8_MMA(0, 0, At, B0); PG8_BAR; PG8_SCHED;
            PG8_LDB(B1, 0, 1); PG8_STAGE(PG8_SB(0, 0), b2, voffB);
            PG8_BAR; PG8_WAIT_L(0); PG8_MMA(0, 1, At, B1); PG8_BAR;
            PG8_LDA(At, 0, 1); PG8_STAGE(PG8_SA(0, 0), a2, xa[0]);
            PG8_BAR; PG8_WAIT_L(0); PG8_MMA(1, 0, At, B0); PG8_BAR; PG8_SCHED;
            PG8_STAGE(PG8_SB(0, 1), b2 + hstep, voffB);
            PG8_WAIT_V(6); PG8_BAR; PG8_MMA(1, 1, At, B1); PG8_BAR;
            PG8_LDB(B0, 1, 0); PG8_SCHED; PG8_LDA(At, 1, 0); PG8_STAGE(PG8_SA(0, 1), a2, xa[1]);
            PG8_WAIT_L(8); PG8_BAR; PG8_WAIT_L(0); PG8_MMA(0, 0, At, B0); PG8_BAR; PG8_SCHED;
            PG8_LDB(B1, 1, 1); PG8_STAGE(PG8_SB(1, 0), b3, voffB);
            PG8_BAR; PG8_WAIT_L(0); PG8_MMA(0, 1, At, B1); PG8_BAR;
            PG8_LDA(At, 1, 1); PG8_STAGE(PG8_SA(1, 0), a3, xa[0]);
            PG8_BAR; PG8_WAIT_L(0); PG8_MMA(1, 0, At, B0); PG8_BAR; PG8_SCHED;
            PG8_STAGE(PG8_SB(1, 1), b3 + hstep, voffB);
            PG8_WAIT_V(6); PG8_BAR; PG8_MMA(1, 1, At, B1); PG8_BAR;
        }
        E(acc, cur, wr, wc, fr, fq);
        if (!has_next) break;
#pragma unroll
        for (int a = 0; a < 2; ++a)
#pragma unroll
            for (int b = 0; b < 2; ++b)
#pragma unroll
                for (int m = 0; m < 4; ++m)
#pragma unroll
                    for (int n = 0; n < 2; ++n) acc[a][b][m][n] = (f32x4){0.f, 0.f, 0.f, 0.f};
        cur = nxt; cB = nB; ++ui;
#pragma unroll
        for (int h = 0; h < 2; ++h)
#pragma unroll
            for (int i = 0; i < 2; ++i) va[h][i] = nva[h][i];
    }
    PG8_WAIT_V(0);
    if (wr == 0) PG8_BAR;
    PG8_BAR;
#undef PG8_SA
#undef PG8_SB
#undef PG8_STAGE
#undef PG8_LDA
#undef PG8_LDB
#undef PG8_MMA
#undef PG8_WAIT_V
#undef PG8_WAIT_L
#undef PG8_BAR
#undef PG8_SCHED
#undef PG8_MKVA
}
}

namespace at {
constexpr int SHM = 16384;
constexpr int L_V = 0, L_K = SHM, L_IMP = 2 * SHM, L_WS = L_IMP + 32768, L_SEL = L_WS + 8 * 512, L_UNI = L_SEL + 8192, L_FLAG = L_UNI + 128;
#define KSWZ(row, colB) ((row) * 256 + ((colB) ^ (((row) & 7) << 4)))
#define SBAR() __builtin_amdgcn_sched_barrier(0)
DI int v_st(int k, int c) { const int kk = (k & ~0xC) | ((k & 4) << 1) | ((k & 8) >> 1); return ((kk >> 3) * 4 + (c >> 5)) * 512 + ((kk & 7) * 32 + (c & 31)) * 2; }
DI int v_rd_base(int lane) { return ((lane & 3) << 3) | (((lane >> 2) & 3) << 6) | (((lane >> 4) & 1) << 5) | (((lane >> 5) & 1) << 8); }
constexpr int v_rd_off(int d0, int ks, int half) { return d0 * 512 + ks * 4096 + half * 2048; }
DI int crow(int r, int hi) { return (r & 3) + 8 * (r >> 2) + 4 * hi; }

DI void qkt(f32x16& p0, f32x16& p1, const LAS char* K_lds, int r32, int hi, const bf16x8* qr) {
    p0 = f32x16{}; p1 = f32x16{};
    const LAS char* kb[4];
#pragma unroll
    for (int dd = 0; dd < 4; ++dd) kb[dd] = K_lds + KSWZ(r32, (dd * 16 + hi * 8) * 2);
#pragma unroll
    for (int d0 = 0; d0 < 8; ++d0) { const LAS char* a = kb[d0 & 3] + (d0 >> 2) * 128;
        const bf16x8 b0 = *(const LAS bf16x8*)a;
        const bf16x8 b1 = *(const LAS bf16x8*)(a + 32 * 256);
        p0 = __builtin_amdgcn_mfma_f32_32x32x16_bf16(b0, qr[d0], p0, 0, 0, 0);
        p1 = __builtin_amdgcn_mfma_f32_32x32x16_bf16(b1, qr[d0], p1, 0, 0, 0); }
}
DI void pv_tile(f32x16* o, int vb0, bf16x8 pa0, bf16x8 pa1, bf16x8 pa2, bf16x8 pa3) {
#define TRRD(dst, off) asm volatile("ds_read_b64_tr_b16 %0, %1 offset:%2" : "=&v"(dst) : "v"(vb0), "i"(off) : "memory")
#define PV_D0(d0) do { s16x4 l0, l1, l2, l3, h0, h1, h2, h3; constexpr int b_ = v_rd_off(d0, 0, 0); \
        TRRD(l0, b_); TRRD(h0, b_ + 2048); TRRD(l1, b_ + 4096); TRRD(h1, b_ + 6144); TRRD(l2, b_ + 8192); TRRD(h2, b_ + 10240); TRRD(l3, b_ + 12288); TRRD(h3, b_ + 14336); \
        asm volatile("s_waitcnt lgkmcnt(0)" ::: "memory"); SBAR(); \
        o[d0] = __builtin_amdgcn_mfma_f32_32x32x16_bf16(pa0, (bf16x8){l0[0], l0[1], l0[2], l0[3], h0[0], h0[1], h0[2], h0[3]}, o[d0], 0, 0, 0); \
        o[d0] = __builtin_amdgcn_mfma_f32_32x32x16_bf16(pa1, (bf16x8){l1[0], l1[1], l1[2], l1[3], h1[0], h1[1], h1[2], h1[3]}, o[d0], 0, 0, 0); \
        o[d0] = __builtin_amdgcn_mfma_f32_32x32x16_bf16(pa2, (bf16x8){l2[0], l2[1], l2[2], l2[3], h2[0], h2[1], h2[2], h2[3]}, o[d0], 0, 0, 0); \
        o[d0] = __builtin_amdgcn_mfma_f32_32x32x16_bf16(pa3, (bf16x8){l3[0], l3[1], l3[2], l3[3], h3[0], h3[1], h3[2], h3[3]}, o[d0], 0, 0, 0); } while (0)
    PV_D0(0); PV_D0(1); PV_D0(2); PV_D0(3);
#undef PV_D0
#undef TRRD
}
DI void pack_p(const f32x16& p0, const f32x16& p1, bf16x8& pa0, bf16x8& pa1, bf16x8& pa2, bf16x8& pa3) {
#define PK4(P, B_, OUT) do { unsigned a0 = cvtpk(P[B_+0], P[B_+1]), a1 = cvtpk(P[B_+2], P[B_+3]); \
        unsigned b0 = cvtpk(P[B_+4], P[B_+5]), b1 = cvtpk(P[B_+6], P[B_+7]); \
        auto r0 = __builtin_amdgcn_permlane32_swap(a0, b0, false, false); auto r1 = __builtin_amdgcn_permlane32_swap(a1, b1, false, false); \
        u32x4 w = {r0[0], r1[0], r0[1], r1[1]}; OUT = __builtin_bit_cast(bf16x8, w); } while (0)
    PK4(p0, 0, pa0); PK4(p0, 8, pa1); PK4(p1, 0, pa2); PK4(p1, 8, pa3);
#undef PK4
}
DI float half_max(float v) { auto rr = __builtin_amdgcn_permlane32_swap(__float_as_uint(v), __float_as_uint(v), false, false); return fmaxf(__uint_as_float(rr[0]), __uint_as_float(rr[1])); }
DI float half_sum(float v) { auto rr = __builtin_amdgcn_permlane32_swap(__float_as_uint(v), __float_as_uint(v), false, false); return __uint_as_float(rr[0]) + __uint_as_float(rr[1]); }

struct TileRegs { bf16x8 k0, k1, v0, v1; };
template <bool NEEDV> DI void tile_load(TileRegs& R, const bf16_t* Kp, const bf16_t* Vp, size_t pitchK, size_t pitchV, int sr, int sc) {
    R.k0 = *(const bf16x8*)(Kp + (size_t)sr * pitchK + sc); R.k1 = *(const bf16x8*)(Kp + (size_t)(sr + 32) * pitchK + sc);
    if (NEEDV) { R.v0 = *(const bf16x8*)(Vp + (size_t)sr * pitchV + sc); R.v1 = *(const bf16x8*)(Vp + (size_t)(sr + 32) * pitchV + sc); }
}
template <bool NEEDV> DI void tile_write(LAS char* lds, const TileRegs& R, int sr, int sc) {
    const int kws = KSWZ(sr, sc * 2);
    *(LAS bf16x8*)(lds + L_K + kws) = R.k0; *(LAS bf16x8*)(lds + L_K + kws + 32 * 256) = R.k1;
    if (NEEDV) { *(LAS bf16x8*)(lds + L_V + v_st(sr, sc)) = R.v0; *(LAS bf16x8*)(lds + L_V + v_st(32 + sr, sc)) = R.v1; }
}
DI unsigned wave_max_u32(unsigned x) { for (int o = 32; o >= 1; o >>= 1) { const unsigned y = (unsigned)__shfl_xor((int)x, o); x = x > y ? x : y; } return x; }

enum { M_CMP1 = 0, M_CMP2 = 1, M_SLC = 2, M_WIN = 3 };

struct NsaCtx {
    LAS char* lds; int tid, wid, lane, r32, hi, sr, sc, vb0;
    int b, g, t0, t;
    float slope2;
    const bf16_t* proj; const bf16_t* kcmp; const bf16_t* vcmp;
    unsigned sel0, sel1, sel2, sel3;
};

template <int MODE>
DI void nsa_pass(const NsaCtx& c, const bf16x8* qr, f32x16* o, float& m_reg, float& l_reg, float inv_l, int nt_or_jlo, int jhi, const unsigned* uni) {
    constexpr bool NEEDV = (MODE != M_CMP1);
    const size_t rowbase = (size_t)c.b * T_;
    const bf16_t* Kb; const bf16_t* Vb; size_t pitch;
    if (MODE == M_CMP1 || MODE == M_CMP2) { Kb = c.kcmp + (size_t)(c.b * 4 + c.g) * 512 * 128; Vb = c.vcmp + (size_t)(c.b * 4 + c.g) * 512 * 128; pitch = 128; }
    else if (MODE == M_SLC) { Kb = c.proj + rowbase * LDP0 + C_KS + c.g * 128; Vb = c.proj + rowbase * LDP0 + C_VS + c.g * 128; pitch = LDP0; }
    else { Kb = c.proj + rowbase * LDP0 + C_KW + c.g * 128; Vb = c.proj + rowbase * LDP0 + C_VW + c.g * 128; pitch = LDP0; }
    LAS float* ws = (LAS float*)(c.lds + L_WS) + c.wid * 128;
    LAS float* imp = (LAS float*)(c.lds + L_IMP) + c.wid * 1024;
    unsigned u0 = 0, u1 = 0, u2 = 0, u3 = 0; int j = 0, jn = 0; bool have, haven;
    if (MODE == M_SLC) { u0 = uni[0]; u1 = uni[1]; u2 = uni[2]; u3 = uni[3]; }
#define NEXT_SLC(jj, hv) do { if (u0) { jj = __builtin_ctz(u0); u0 &= u0 - 1; hv = true; } else if (u1) { jj = 32 + __builtin_ctz(u1); u1 &= u1 - 1; hv = true; } \
        else if (u2) { jj = 64 + __builtin_ctz(u2); u2 &= u2 - 1; hv = true; } else if (u3) { jj = 96 + __builtin_ctz(u3); u3 &= u3 - 1; hv = true; } else hv = false; } while (0)
    if (MODE == M_SLC) { NEXT_SLC(j, have); } else if (MODE == M_WIN) { j = nt_or_jlo; have = j <= jhi; } else { j = 0; have = j < nt_or_jlo; }
    TileRegs R;
    if (have) tile_load<NEEDV>(R, Kb + (size_t)j * 64 * pitch, Vb + (size_t)j * 64 * pitch, pitch, pitch, c.sr, c.sc);
    const int twmax = c.t0 + c.wid * 8 + 7;
    while (have) {
        __syncthreads();
        tile_write<NEEDV>(c.lds, R, c.sr, c.sc);
        __syncthreads();
        if (MODE == M_SLC) { NEXT_SLC(jn, haven); } else if (MODE == M_WIN) { jn = j + 1; haven = jn <= jhi; } else { jn = j + 1; haven = jn < nt_or_jlo; }
        if (haven) tile_load<NEEDV>(R, Kb + (size_t)jn * 64 * pitch, Vb + (size_t)jn * 64 * pitch, pitch, pitch, c.sr, c.sc);
        bool act; unsigned selbit = 0;
        if (MODE == M_CMP1 || MODE == M_CMP2) act = (j * 1024 + 31) <= twmax;
        else if (MODE == M_SLC) { const unsigned wsel = (j < 32) ? c.sel0 : (j < 64) ? c.sel1 : (j < 96) ? c.sel2 : c.sel3; selbit = (wsel >> (j & 31)) & 1u; act = __any(selbit != 0u); }
        else act = true;
        if (act) {
            f32x16 p0, p1;
            qkt(p0, p1, c.lds + L_K, c.r32, c.hi, qr);
            const float NEG = -__builtin_inff();
            if (MODE == M_CMP1 || MODE == M_CMP2) {
                const int dq = c.t - 31 - 1024 * j - 64 * c.hi; const float base = -c.slope2 * (float)dq, s16 = c.slope2 * 16.f;
#pragma unroll
                for (int r = 0; r < 16; ++r) { const int cc = (r & 3) + 8 * (r >> 2);
                    p0[r] = (dq - 16 * cc >= 0) ? fmaf(s16, (float)cc, p0[r] + base) : NEG;
                    p1[r] = (dq - 16 * cc - 512 >= 0) ? fmaf(s16, (float)(cc + 32), p1[r] + base) : NEG; }
            } else {
                const int dq = c.t - 64 * j - 4 * c.hi; const float base = -c.slope2 * (float)dq;
#pragma unroll
                for (int r = 0; r < 16; ++r) { const int cc = (r & 3) + 8 * (r >> 2);
                    bool v0, v1;
                    if (MODE == M_SLC) { v0 = selbit && (dq - cc >= 0); v1 = selbit && (dq - cc - 32 >= 0); }
                    else { v0 = (unsigned)(dq - cc) < 512u; v1 = (unsigned)(dq - cc - 32) < 512u; }
                    p0[r] = v0 ? fmaf(c.slope2, (float)cc, p0[r] + base) : NEG;
                    p1[r] = v1 ? fmaf(c.slope2, (float)(cc + 32), p1[r] + base) : NEG; }
            }
            if (MODE == M_CMP2) {
#pragma unroll
                for (int r = 0; r < 16; ++r) { p0[r] = __builtin_amdgcn_exp2f(p0[r] - m_reg) * inv_l; p1[r] = __builtin_amdgcn_exp2f(p1[r] - m_reg) * inv_l; }
                const int q8 = c.r32 >> 2; const bool owner = (c.r32 & 3) == 0;
#pragma unroll
                for (int hf = 0; hf < 2; ++hf)
#pragma unroll
                    for (int gi = 0; gi < 4; ++gi) {
                        const float x0 = hf ? p1[4 * gi] : p0[4 * gi], x1 = hf ? p1[4 * gi + 1] : p0[4 * gi + 1], x2 = hf ? p1[4 * gi + 2] : p0[4 * gi + 2], x3 = hf ? p1[4 * gi + 3] : p0[4 * gi + 3];
                        float cy = 0.5f * x3, w = (x0 + x1) + (x2 + cy);
                        w += __shfl_xor(w, 1); w += __shfl_xor(w, 2); cy += __shfl_xor(cy, 1); cy += __shfl_xor(cy, 2);
                        const int js = j * 16 + hf * 8 + 2 * gi + c.hi;
                        if (owner) imp[q8 * 128 + js] += w;
                        asm volatile("s_waitcnt lgkmcnt(0)" ::: "memory");
                        if (owner && js + 1 < 128) imp[q8 * 128 + js + 1] += cy;
                        asm volatile("s_waitcnt lgkmcnt(0)" ::: "memory");
                    }
                bf16x8 pa0, pa1, pa2, pa3; pack_p(p0, p1, pa0, pa1, pa2, pa3);
                pv_tile(o, c.vb0, pa0, pa1, pa2, pa3);
            } else {
                float pmax = p0[0];
#pragma unroll
                for (int r = 1; r < 16; ++r) pmax = fmaxf(pmax, p0[r]);
#pragma unroll
                for (int r = 0; r < 16; ++r) pmax = fmaxf(pmax, p1[r]);
                pmax = half_max(pmax);
                const float mn = fmaxf(m_reg, pmax), alpha = __builtin_amdgcn_exp2f(m_reg - mn); m_reg = mn;
                float ps = 0.f;
#pragma unroll
                for (int r = 0; r < 16; ++r) { p0[r] = __builtin_amdgcn_exp2f(p0[r] - mn); p1[r] = __builtin_amdgcn_exp2f(p1[r] - mn); ps += p0[r] + p1[r]; }
                ps = half_sum(ps);
                l_reg = l_reg * alpha + ps;
                if (MODE != M_CMP1) {
                    if (__any(alpha < 1.f)) { if (c.hi == 0) ws[32 + c.r32] = alpha; asm volatile("s_waitcnt lgkmcnt(0)" ::: "memory");
#pragma unroll
                        for (int r = 0; r < 16; ++r) { const float a = ws[32 + crow(r, c.hi)];
#pragma unroll
                            for (int d = 0; d < 4; ++d) o[d][r] *= a; } }
                    bf16x8 pa0, pa1, pa2, pa3; pack_p(p0, p1, pa0, pa1, pa2, pa3);
                    pv_tile(o, c.vb0, pa0, pa1, pa2, pa3);
                }
            }
        }
        j = jn; have = haven;
    }
#undef NEXT_SLC
}

template <bool ACCUM> DI void nsa_store(const NsaCtx& c, const f32x16* o, float rowscale, bf16_t* att) {
    LAS float* ws = (LAS float*)(c.lds + L_WS) + c.wid * 128;
    if (c.hi == 0) ws[c.r32] = rowscale;
    asm volatile("s_waitcnt lgkmcnt(0)" ::: "memory");
#pragma unroll
    for (int r = 0; r < 16; ++r) { const int row = crow(r, c.hi); const float s = ws[row]; const int tq = c.t0 + c.wid * 8 + (row >> 2), hd = c.g * 4 + (row & 3);
        bf16_t* op = att + (size_t)(c.b * T_ + tq) * DM + hd * 128;
#pragma unroll
        for (int d0 = 0; d0 < 4; ++d0) { float v = o[d0][r] * s; float vn = __shfl_xor(v, 1);
            if ((c.r32 & 1) == 0) { unsigned* p = (unsigned*)(op + d0 * 32 + c.r32);
                if (ACCUM) { const unsigned prev = *p; v += bflo(prev); vn += bfhi(prev); }
                *p = cvtpk(v, vn); } } }
    asm volatile("s_waitcnt lgkmcnt(0)" ::: "memory");
}
DI void nsa_setup(NsaCtx& c, LAS char* lds, int item, const bf16_t* proj, const bf16_t* kcmp, const bf16_t* vcmp, const float* qk_gain, bf16x8* qr, float* gate) {
    c.lds = lds; c.tid = threadIdx.x; c.wid = __builtin_amdgcn_readfirstlane(c.tid >> 6); c.lane = c.tid & 63; c.r32 = c.lane & 31; c.hi = c.lane >> 5;
    c.sr = c.tid >> 4; c.sc = (c.tid & 15) * 8; c.vb0 = (int)(unsigned)(uintptr_t)(lds + L_V) + v_rd_base(c.lane);
    c.b = item >> 9; c.g = (item >> 7) & 3; c.t0 = (item & 127) * 64;
    c.proj = proj; c.kcmp = kcmp; c.vcmp = vcmp;
    const int q8 = c.r32 >> 2, hr = c.r32 & 3, head = c.g * 4 + hr; c.t = c.t0 + c.wid * 8 + q8;
    c.slope2 = __builtin_amdgcn_exp2f(-0.5f * (float)(head + 1)) * LOG2E;
    const size_t tokrow = (size_t)(c.b * T_ + c.t) * LDP0;
    float qf[64]; float ss = 0.f;
    const bf16_t* qp = proj + tokrow + C_Q + head * 128 + c.hi * 8;
#pragma unroll
    for (int d0 = 0; d0 < 8; ++d0) { const u32x4 raw = *(const u32x4*)(qp + d0 * 16);
#pragma unroll
        for (int e = 0; e < 4; ++e) { const float a = bflo(raw[e]), bq = bfhi(raw[e]); qf[d0 * 8 + 2 * e] = a; qf[d0 * 8 + 2 * e + 1] = bq; ss += a * a + bq * bq; } }
    ss = half_sum(ss);
    const float rs = __builtin_amdgcn_rsqf(ss * (1.0f / 128.0f) + 1e-6f) * (QSCALE * LOG2E);
#pragma unroll
    for (int d0 = 0; d0 < 8; ++d0) { const float* gp = qk_gain + d0 * 16 + c.hi * 8; const f32x4 g0 = *(const f32x4*)gp, g1 = *(const f32x4*)(gp + 4);
        f32x4 a = {qf[d0 * 8] * rs * g0[0], qf[d0 * 8 + 1] * rs * g0[1], qf[d0 * 8 + 2] * rs * g0[2], qf[d0 * 8 + 3] * rs * g0[3]};
        f32x4 bq = {qf[d0 * 8 + 4] * rs * g1[0], qf[d0 * 8 + 5] * rs * g1[1], qf[d0 * 8 + 6] * rs * g1[2], qf[d0 * 8 + 7] * rs * g1[3]};
        qr[d0] = pack8(a, bq); }
#pragma unroll
    for (int br = 0; br < 3; ++br) { const float x = bflo((unsigned)proj[tokrow + C_GT + br * 16 + head]); gate[br] = __builtin_amdgcn_rcpf(1.0f + __builtin_amdgcn_exp2f(-x * LOG2E)); }
}
DI void nsa_cmp_item(LAS char* lds, int item, int slot, const bf16_t* proj, const bf16_t* kcmp, const bf16_t* vcmp, const float* qk_gain, bf16_t* att) {
    NsaCtx c; bf16x8 qr[8]; float gate[3];
    nsa_setup(c, lds, item, proj, kcmp, vcmp, qk_gain, qr, gate);
    LAS float* imp = (LAS float*)(lds + L_IMP) + c.wid * 1024;
#pragma unroll
    for (int i = 0; i < 16; ++i) imp[i * 64 + c.lane] = 0.f;
    LAS unsigned* selm = (LAS unsigned*)(lds + L_SEL) + slot * 256;
    LAS unsigned* uni = (LAS unsigned*)(lds + L_UNI) + slot * 4;
    if (c.tid < 4) uni[c.tid] = 0u;
    f32x16 o[4] = {};
    int nkt = ((c.t0 >> 4) + 2) / 64 + 1; if (nkt > 8) nkt = 8;
    float m_c = -1e30f, l_c = 0.f;
    nsa_pass<M_CMP1>(c, qr, o, m_c, l_c, 0.f, nkt, 0, nullptr);
    const float inv_l = l_c > 0.f ? __builtin_amdgcn_rcpf(l_c) : 0.f;
    nsa_pass<M_CMP2>(c, qr, o, m_c, l_c, inv_l, nkt, 0, nullptr);
    nsa_store<false>(c, o, gate[0], att);
    for (int q = 0; q < 8; ++q) {
        const int tq = c.t0 + c.wid * 8 + q, jd = tq >> 6;
        const float v0 = imp[q * 128 + c.lane], v1 = imp[q * 128 + 64 + c.lane];
        const int j0 = c.lane, j1 = c.lane + 64;
        unsigned k0 = j0 > jd ? 0u : (((j0 == 0 || j0 == jd) ? 0x80000000u : (((__float_as_uint(v0) >> 7) + 1u) << 7)) | (unsigned)(127 - j0));
        unsigned k1 = j1 > jd ? 0u : (((j1 == jd) ? 0x80000000u : (((__float_as_uint(v1) >> 7) + 1u) << 7)) | (unsigned)(127 - j1));
        bool s0 = false, s1 = false;
        for (int it = 0; it < 16; ++it) {
            const unsigned mx = wave_max_u32(k0 > k1 ? k0 : k1);
            if (mx == 0u) break;
            const int jw = 127 - (int)(mx & 127u);
            if (jw == j0) { s0 = true; k0 = 0u; }
            if (jw == j1) { s1 = true; k1 = 0u; }
        }
        const unsigned long long lo = __ballot(s0), hi64 = __ballot(s1);
        if (c.lane == 0) { const int qi = (c.wid * 8 + q) * 4;
            selm[qi] = (unsigned)lo; selm[qi + 1] = (unsigned)(lo >> 32); selm[qi + 2] = (unsigned)hi64; selm[qi + 3] = (unsigned)(hi64 >> 32);
            __hip_atomic_fetch_or(uni + 0, (unsigned)lo, __ATOMIC_RELAXED, __HIP_MEMORY_SCOPE_WORKGROUP); __hip_atomic_fetch_or(uni + 1, (unsigned)(lo >> 32), __ATOMIC_RELAXED, __HIP_MEMORY_SCOPE_WORKGROUP);
            __hip_atomic_fetch_or(uni + 2, (unsigned)hi64, __ATOMIC_RELAXED, __HIP_MEMORY_SCOPE_WORKGROUP); __hip_atomic_fetch_or(uni + 3, (unsigned)(hi64 >> 32), __ATOMIC_RELAXED, __HIP_MEMORY_SCOPE_WORKGROUP); }
    }
    __syncthreads();
}
DI void nsa_slc_item(LAS char* lds, int item, int slot, const bf16_t* proj, const float* qk_gain, bf16_t* att) {
    NsaCtx c; bf16x8 qr[8]; float gate[3];
    nsa_setup(c, lds, item, proj, nullptr, nullptr, qk_gain, qr, gate);
    unsigned uni[4];
    {
        const LAS unsigned* selm = (const LAS unsigned*)(lds + L_SEL) + slot * 256; const LAS unsigned* un = (const LAS unsigned*)(lds + L_UNI) + slot * 4;
#pragma unroll
        for (int i = 0; i < 4; ++i) uni[i] = (unsigned)__builtin_amdgcn_readfirstlane((int)un[i]);
        const int qi = (c.wid * 8 + (c.r32 >> 2)) * 4; c.sel0 = selm[qi]; c.sel1 = selm[qi + 1]; c.sel2 = selm[qi + 2]; c.sel3 = selm[qi + 3];
    }
    f32x16 o[4] = {};
    float m_s = -1e30f, l_s = 0.f;
    nsa_pass<M_SLC>(c, qr, o, m_s, l_s, 0.f, 0, 0, uni);
    nsa_store<true>(c, o, gate[1] * (l_s > 0.f ? __builtin_amdgcn_rcpf(l_s) : 0.f), att);
    __syncthreads();
}
DI void nsa_win_item(LAS char* lds, int item, const bf16_t* proj, const float* qk_gain, bf16_t* att) {
    NsaCtx c; bf16x8 qr[8]; float gate[3];
    nsa_setup(c, lds, item, proj, nullptr, nullptr, qk_gain, qr, gate);
    f32x16 o[4] = {};
    float m_w = -1e30f, l_w = 0.f;
    const int jhi = c.t0 >> 6, jlo = jhi - 8 > 0 ? jhi - 8 : 0;
    nsa_pass<M_WIN>(c, qr, o, m_w, l_w, 0.f, jlo, jhi, nullptr);
    nsa_store<true>(c, o, gate[2] * (l_w > 0.f ? __builtin_amdgcn_rcpf(l_w) : 0.f), att);
    __syncthreads();
}
}

namespace at {
DI void sb_item(LAS char* lds, int item, const bf16_t* proj, bf16_t* att) {
    const int tid = threadIdx.x, wid = __builtin_amdgcn_readfirstlane(tid >> 6), lane = tid & 63, r32 = lane & 31, hi = lane >> 5;
    const int sr = tid >> 4, sc = (tid & 15) * 8, vb0 = (int)(unsigned)(uintptr_t)(lds + L_V) + v_rd_base(lane);
    const int b = item >> 9, h = (item >> 5) & 15, qb = item & 31, q0 = qb * 256, t = q0 + wid * 32 + r32;
    bf16x8 qr[8];
    {
        const bf16_t* qp = proj + (size_t)(b * T_ + t) * LDP1 + h * 128 + hi * 8; const float sc2 = QSCALE * LOG2E;
#pragma unroll
        for (int d0 = 0; d0 < 8; ++d0) { const u32x4 raw = *(const u32x4*)(qp + d0 * 16);
            f32x4 a = {bflo(raw[0]) * sc2, bfhi(raw[0]) * sc2, bflo(raw[1]) * sc2, bfhi(raw[1]) * sc2}, bq = {bflo(raw[2]) * sc2, bfhi(raw[2]) * sc2, bflo(raw[3]) * sc2, bfhi(raw[3]) * sc2};
            qr[d0] = pack8(a, bq); }
    }
    LAS unsigned* flg = (LAS unsigned*)(lds + L_FLAG);
    if (tid < 8) flg[tid] = 0u;
    const bf16_t* Kb = proj + (size_t)b * T_ * LDP1 + DM + h * 128; const bf16_t* Vb = proj + (size_t)b * T_ * LDP1 + 2 * DM + h * 128;
    f32x16 o[4] = {}; float carry = 0.f; bool wdone = false;
    const int twmax = q0 + wid * 32 + 31;
    int jt = qb * 4 + 3;
    TileRegs R; tile_load<true>(R, Kb + (size_t)jt * 64 * LDP1, Vb + (size_t)jt * 64 * LDP1, LDP1, LDP1, sr, sc);
    for (;;) {
        __syncthreads();
        unsigned nd = 0;
#pragma unroll
        for (int i = 0; i < 8; ++i) nd += flg[i];
        if (__builtin_amdgcn_readfirstlane((int)nd) == 8) break;
        tile_write<true>(lds, R, sr, sc);
        __syncthreads();
        const int jn = jt - 1;
        if (jn >= 0) tile_load<true>(R, Kb + (size_t)jn * 64 * LDP1, Vb + (size_t)jn * 64 * LDP1, LDP1, LDP1, sr, sc);
        if (!wdone && 64 * jt < twmax) {
            f32x16 p0, p1;
            qkt(p0, p1, lds + L_K, r32, hi, qr);
            const int dq = t - 64 * jt - 4 * hi;
            f32x16 l0, l1;
            const float NEG = -__builtin_inff();
#pragma unroll
            for (int r = 0; r < 16; ++r) { const int cc = (r & 3) + 8 * (r >> 2);
                { const float z = p0[r]; const float sp = fmaxf(z, 0.f) + __builtin_amdgcn_logf(1.0f + __builtin_amdgcn_exp2f(-fabsf(z))); const bool v = (dq - cc) > 0; l0[r] = v ? -sp : 0.f; p0[r] = v ? z - sp : NEG; }
                { const float z = p1[r]; const float sp = fmaxf(z, 0.f) + __builtin_amdgcn_logf(1.0f + __builtin_amdgcn_exp2f(-fabsf(z))); const bool v = (dq - cc - 32) > 0; l1[r] = v ? -sp : 0.f; p1[r] = v ? z - sp : NEG; } }
            float own[8], par[8], aft[8];
#pragma unroll
            for (int gi = 0; gi < 4; ++gi) { own[gi] = (l0[4 * gi] + l0[4 * gi + 1]) + (l0[4 * gi + 2] + l0[4 * gi + 3]); own[4 + gi] = (l1[4 * gi] + l1[4 * gi + 1]) + (l1[4 * gi + 2] + l1[4 * gi + 3]); }
#pragma unroll
            for (int pi = 0; pi < 8; ++pi) par[pi] = __shfl_xor(own[pi], 32);
            float run = 0.f;
#pragma unroll
            for (int pi = 7; pi >= 0; --pi) { aft[pi] = run + (hi == 0 ? par[pi] : 0.f); run += own[pi] + par[pi]; }
#pragma unroll
            for (int gi = 0; gi < 4; ++gi) {
                { float a = carry + aft[gi]; p0[4 * gi + 3] = __builtin_amdgcn_exp2f(p0[4 * gi + 3] + a); a += l0[4 * gi + 3]; p0[4 * gi + 2] = __builtin_amdgcn_exp2f(p0[4 * gi + 2] + a); a += l0[4 * gi + 2];
                  p0[4 * gi + 1] = __builtin_amdgcn_exp2f(p0[4 * gi + 1] + a); a += l0[4 * gi + 1]; p0[4 * gi] = __builtin_amdgcn_exp2f(p0[4 * gi] + a); }
                { float a = carry + aft[4 + gi]; p1[4 * gi + 3] = __builtin_amdgcn_exp2f(p1[4 * gi + 3] + a); a += l1[4 * gi + 3]; p1[4 * gi + 2] = __builtin_amdgcn_exp2f(p1[4 * gi + 2] + a); a += l1[4 * gi + 2];
                  p1[4 * gi + 1] = __builtin_amdgcn_exp2f(p1[4 * gi + 1] + a); a += l1[4 * gi + 1]; p1[4 * gi] = __builtin_amdgcn_exp2f(p1[4 * gi] + a); } }
            carry += run;
            bf16x8 pa0, pa1, pa2, pa3; pack_p(p0, p1, pa0, pa1, pa2, pa3);
            pv_tile(o, vb0, pa0, pa1, pa2, pa3);
            if (__all(carry < -160.f)) { wdone = true; if (lane == 0) flg[wid] = 1u; }
        }
        if (jn < 0) break;
        jt = jn;
    }
    bf16_t* op = att + (size_t)(b * T_ + q0 + wid * 32) * DM + h * 128;
#pragma unroll
    for (int r = 0; r < 16; ++r) { const int row = crow(r, hi);
#pragma unroll
        for (int d0 = 0; d0 < 4; ++d0) { const float v = o[d0][r]; const float vn = __shfl_xor(v, 1);
            if ((r32 & 1) == 0) *(unsigned*)(op + (size_t)row * DM + d0 * 32 + r32) = cvtpk(v, vn); } }
    __syncthreads();
}
}

DI void tconv_tile(const float* src, int ld, int nvalid, int k0, int n0, bf16_t* dst, int dld, LAS unsigned char* lds) {
    const int tid = threadIdx.x;
    constexpr int RS = 264;
    __syncthreads();
#pragma unroll
    for (int i = 0; i < 8; ++i) { const int idx = tid + 512 * i, k = idx >> 5, n4 = idx & 31;
        f32x4 v = {0.f, 0.f, 0.f, 0.f};
        if (n0 + 4 * n4 < nvalid) v = *(const f32x4*)(src + (size_t)(k0 + k) * ld + n0 + 4 * n4);
        u32x2 w = {cvtpk(v[0], v[1]), cvtpk(v[2], v[3])};
        *(LAS u32x2*)(lds + k * RS + n4 * 8) = w; }
    __syncthreads();
    const int n = tid & 127, kq = tid >> 7;
#pragma unroll
    for (int j = 0; j < 4; ++j) { unsigned short e[8];
#pragma unroll
        for (int q = 0; q < 8; ++q) e[q] = *(const LAS unsigned short*)(lds + (kq * 32 + j * 8 + q) * RS + n * 2);
        u32x4 w = {(unsigned)e[0] | ((unsigned)e[1] << 16), (unsigned)e[2] | ((unsigned)e[3] << 16), (unsigned)e[4] | ((unsigned)e[5] << 16), (unsigned)e[6] | ((unsigned)e[7] << 16)};
        *(u32x4*)(dst + (size_t)n * dld + k0 + kq * 32 + j * 8) = w; }
}
DI void norm_row(const float* xrow, const float* g, bf16_t* hrow, int lane) {
    f32x4 v[8]; float ss = 0.f;
#pragma unroll
    for (int i = 0; i < 8; ++i) { v[i] = *(const f32x4*)(xrow + i * 256 + lane * 4); ss += (v[i][0] * v[i][0] + v[i][1] * v[i][1]) + (v[i][2] * v[i][2] + v[i][3] * v[i][3]); }
    ss = wave_sum(ss);
    const float rs = __builtin_amdgcn_rsqf(ss * (1.0f / 2048.0f) + 1e-6f);
#pragma unroll
    for (int i = 0; i < 8; ++i) { const f32x4 gg = *(const f32x4*)(g + i * 256 + lane * 4);
        u32x2 w = {cvtpk(v[i][0] * rs * gg[0], v[i][1] * rs * gg[1]), cvtpk(v[i][2] * rs * gg[2], v[i][3] * rs * gg[3])};
        *(u32x2*)(hrow + i * 256 + lane * 4) = w; }
}

struct Args { const float* in[18]; float* out; unsigned char* ws; int ph_lo, ph_hi; };

DI void phase_prologue(const Args& a, LAS unsigned char* lds) {
    const int tid = threadIdx.x, wid = tid >> 6, lane = tid & 63, G = gridDim.x, bx = blockIdx.x;
    unsigned char* ws = a.ws;
    constexpr int J0 = 672, J1 = J0 + 256, J2 = J1 + 768, J3 = J2 + 256, J4 = J3 + 4096, J5 = J4 + 4096, J6 = J5 + 4096, J7 = J6 + 64, J8 = J7 + 2;
    for (int job = bx; job < J8; job += G) {
        const float* src; int ld, nvalid, K, kt, n0; bf16_t* dst;
        if (job < J0) { const int i = job; kt = i % 16; n0 = (i / 16) * 128; src = a.in[3]; ld = 5168; nvalid = 5168; K = 2048; dst = (bf16_t*)(ws + WS_WIN0) + (size_t)n0 * K; }
        else if (job < J1) { const int i = job - J0; kt = i % 16; n0 = (i / 16) * 128; src = a.in[8]; ld = 2048; nvalid = 2048; K = 2048; dst = (bf16_t*)(ws + WS_WOUT0) + (size_t)n0 * K; }
        else if (job < J2) { const int i = job - J1; kt = i % 16; n0 = (i / 16) * 128; src = a.in[9]; ld = 6144; nvalid = 6144; K = 2048; dst = (bf16_t*)(ws + WS_WIN1) + (size_t)n0 * K; }
        else if (job < J3) { const int i = job - J2; kt = i % 16; n0 = (i / 16) * 128; src = a.in[10]; ld = 2048; nvalid = 2048; K = 2048; dst = (bf16_t*)(ws + WS_WOUT1) + (size_t)n0 * K; }
        else if (job < J5) { const bool up = job >= J4; const int i = job - (up ? J4 : J3); const int mat = i >> 6, r = i & 63; kt = r % 16; n0 = (r / 16) * 128;
            src = a.in[up ? 16 : 15] + (size_t)mat * 2048 * 512; ld = 512; nvalid = 512; K = 2048;
            dst = (bf16_t*)(ws + WS_W1) + ((size_t)mat * 1024 + (n0 / 128) * 256 + (up ? 128 : 0)) * K; }
        else if (job < J6) { const int i = job - J5; const int mat = i >> 6, r = i & 63; kt = r % 4; n0 = (r / 4) * 128;
            src = a.in[17] + (size_t)mat * 512 * 2048; ld = 2048; nvalid = 2048; K = 512; dst = (bf16_t*)(ws + WS_W2) + ((size_t)mat * 2048 + n0) * K; }
        else if (job < J7) { const int i = job - J6; const int kv = i >> 5; kt = i & 31; n0 = 0; src = a.in[6] + (size_t)kv * 4096 * 128; ld = 128; nvalid = 128; K = 4096; dst = (bf16_t*)(ws + WS_CW1) + (size_t)kv * 128 * K; }
        else { const int kv = job - J7; kt = 0; n0 = 0; src = a.in[7] + (size_t)kv * 128 * 128; ld = 128; nvalid = 128; K = 128; dst = (bf16_t*)(ws + WS_CW2) + (size_t)kv * 128 * K; }
        tconv_tile(src, ld, nvalid, kt * 128, n0, dst, K, lds);
    }
    for (int i = bx * 512 + tid; i < 2 * 256 * 2048; i += G * 512) { const int k = i & 2047, r = (i >> 11) & 255, L = i >> 19;
        float v = 0.f; if (r < 4) v = a.in[11][((size_t)L * 2048 + k) * 4 + r]; else if (r < 36) v = a.in[13][((size_t)L * 2048 + k) * 32 + (r - 4)];
        ((bf16_t*)(ws + WS_WR))[i] = (bf16_t)(cvtpk(v, 0.f) & 0xffffu); }
    for (int o = bx * 8 + wid; o < 256; o += G * 8) { const int kv = o >> 7, f = o & 127; float s = 0.f;
        for (int kk = lane; kk < 4096; kk += 64) s += a.in[5][kv * 4096 + kk] * a.in[6][((size_t)kv * 4096 + kk) * 128 + f];
        s = wave_sum(s); if (lane == 0) ((float*)(ws + WS_BIAS1))[o] = s; }
    for (int row = bx * 8 + wid; row < NTOK; row += G * 8) norm_row(a.in[0] + (size_t)row * DM, a.in[1], (bf16_t*)(ws + WS_H) + (size_t)row * DM, lane);
}

DI void phase_norm(const float* x, const float* g, bf16_t* h) {
    const int tid = threadIdx.x, wid = tid >> 6, lane = tid & 63;
    for (int row = blockIdx.x * 8 + wid; row < NTOK; row += gridDim.x * 8) norm_row(x + (size_t)row * DM, g, h + (size_t)row * DM, lane);
}

DI void cmp_item(LAS unsigned char* lds, int item, const bf16_t* proj, const bf16_t* cw1t, const bf16_t* cw2t, const float* bias1, const float* gain1, bf16_t* kcmp, bf16_t* vcmp) {
    const int tid = threadIdx.x, wid = __builtin_amdgcn_readfirstlane(tid >> 6), lane = tid & 63, fr = lane & 15, fq = lane >> 4;
    const int kv = item >> 7, rt = item & 127, bg = rt >> 4, n0 = (rt & 15) * 32, b = bg >> 2, g = bg & 3;
    const bf16_t* abase = proj + (size_t)b * T_ * LDP0 + C_KC + kv * 512 + g * 128 + fq * 8;
    const bf16_t* bbase = cw1t + (size_t)(kv * 128 + wid * 16 + fr) * 4096 + fq * 8;
    f32x4 acc[2] = {{0.f, 0.f, 0.f, 0.f}, {0.f, 0.f, 0.f, 0.f}};
    const int tk0 = 16 * (n0 + fr), tk1 = 16 * (n0 + 16 + fr);
#pragma unroll 4
    for (int ks = 0; ks < 128; ++ks) { const int l = ks >> 2, dp = (ks & 3) * 32;
        int ta = tk0 + l, tb = tk1 + l; ta = ta < T_ ? ta : T_ - 1; tb = tb < T_ ? tb : T_ - 1;
        const bf16x8 a0 = *(const bf16x8*)(abase + (size_t)ta * LDP0 + dp), a1 = *(const bf16x8*)(abase + (size_t)tb * LDP0 + dp);
        const bf16x8 bb = *(const bf16x8*)(bbase + ks * 32);
        acc[0] = __builtin_amdgcn_mfma_f32_16x16x32_bf16(a0, bb, acc[0], 0, 0, 0);
        acc[1] = __builtin_amdgcn_mfma_f32_16x16x32_bf16(a1, bb, acc[1], 0, 0, 0); }
    constexpr int HP = 272;
    const float b1 = bias1[kv * 128 + wid * 16 + fr];
    __syncthreads();
#pragma unroll
    for (int rb = 0; rb < 2; ++rb)
#pragma unroll
        for (int j = 0; j < 4; ++j) { const float x = acc[rb][j] + b1; const float u = 0.7978845608028654f * (x + 0.044715f * x * x * x);
            const float hv = x * __builtin_amdgcn_rcpf(1.0f + __builtin_amdgcn_exp2f(-2.0f * LOG2E * u));
            *(LAS unsigned short*)(lds + (rb * 16 + fq * 4 + j) * HP + (wid * 16 + fr) * 2) = (unsigned short)(cvtpk(hv, 0.f) & 0xffffu); }
    __syncthreads();
    f32x4 ac2[2] = {{0.f, 0.f, 0.f, 0.f}, {0.f, 0.f, 0.f, 0.f}};
    const bf16_t* b2base = cw2t + (size_t)(kv * 128 + wid * 16 + fr) * 128 + fq * 8;
#pragma unroll
    for (int ks = 0; ks < 4; ++ks) { const bf16x8 bb = *(const bf16x8*)(b2base + ks * 32);
#pragma unroll
        for (int rb = 0; rb < 2; ++rb) { const bf16x8 aa = *(const LAS bf16x8*)(lds + (rb * 16 + fr) * HP + (ks * 32 + fq * 8) * 2);
            ac2[rb] = __builtin_amdgcn_mfma_f32_16x16x32_bf16(aa, bb, ac2[rb], 0, 0, 0); } }
    LAS float* part = (LAS float*)(lds + 32 * HP);
    float scl[2][4];
    if (kv == 0) {
#pragma unroll
        for (int rb = 0; rb < 2; ++rb)
#pragma unroll
            for (int j = 0; j < 4; ++j) { float s = ac2[rb][j] * ac2[rb][j]; s += __shfl_xor(s, 1); s += __shfl_xor(s, 2); s += __shfl_xor(s, 4); s += __shfl_xor(s, 8);
                if (fr == 0) part[wid * 32 + rb * 16 + fq * 4 + j] = s; }
        __syncthreads();
        const float gn = gain1[wid * 16 + fr];
#pragma unroll
        for (int rb = 0; rb < 2; ++rb)
#pragma unroll
            for (int j = 0; j < 4; ++j) { float s = 0.f;
#pragma unroll
                for (int w = 0; w < 8; ++w) s += part[w * 32 + rb * 16 + fq * 4 + j];
                scl[rb][j] = __builtin_amdgcn_rsqf(s * (1.0f / 128.0f) + 1e-6f) * gn; }
    } else {
#pragma unroll
        for (int rb = 0; rb < 2; ++rb)
#pragma unroll
            for (int j = 0; j < 4; ++j) scl[rb][j] = 1.0f;
    }
    bf16_t* dst = (kv == 0 ? kcmp : vcmp) + (size_t)(bg * 512 + n0) * 128 + wid * 16 + fr;
#pragma unroll
    for (int rb = 0; rb < 2; ++rb)
#pragma unroll
        for (int j = 0; j < 4; ++j) dst[(size_t)(rb * 16 + fq * 4 + j) * 128] = (bf16_t)(cvtpk(ac2[rb][j] * scl[rb][j], 0.f) & 0xffffu);
    __syncthreads();
}
DI void knorm_phase(bf16_t* proj, const float* qk_gain) {
    const int gid = blockIdx.x * 512 + threadIdx.x, sub = gid & 15;
    for (int rowid = gid >> 4; rowid < NTOK * 8; rowid += gridDim.x * 32) { const int tok = rowid >> 3, selw = (rowid >> 2) & 1, g = rowid & 3;
        bf16_t* p = proj + (size_t)tok * LDP0 + (selw ? C_KW : C_KS) + g * 128 + sub * 8;
        const u32x4 raw = *(const u32x4*)p; float f[8]; float ss = 0.f;
#pragma unroll
        for (int e = 0; e < 4; ++e) { f[2 * e] = bflo(raw[e]); f[2 * e + 1] = bfhi(raw[e]); ss += f[2 * e] * f[2 * e] + f[2 * e + 1] * f[2 * e + 1]; }
        ss += __shfl_xor(ss, 1); ss += __shfl_xor(ss, 2); ss += __shfl_xor(ss, 4); ss += __shfl_xor(ss, 8);
        const float rs = __builtin_amdgcn_rsqf(ss * (1.0f / 128.0f) + 1e-6f);
        const float* gp = qk_gain + (selw ? 3 : 2) * 128 + sub * 8; const f32x4 g0 = *(const f32x4*)gp, g1 = *(const f32x4*)(gp + 4);
        u32x4 w = {cvtpk(f[0] * rs * g0[0], f[1] * rs * g0[1]), cvtpk(f[2] * rs * g0[2], f[3] * rs * g0[3]), cvtpk(f[4] * rs * g1[0], f[5] * rs * g1[1]), cvtpk(f[6] * rs * g1[2], f[7] * rs * g1[3])};
        *(u32x4*)p = w; }
}

DI void route_phase(LAS unsigned char* lds, const float* logits, const float* bgp, const float* brp, unsigned* cnt, int* rows, float* tokinfo) {
    const int tid = threadIdx.x;
    LAS unsigned* hist = (LAS unsigned*)lds; LAS unsigned* base = hist + 32;
    for (int chunk = blockIdx.x; chunk < NTOK / 64; chunk += gridDim.x) {
        __syncthreads();
        if (tid < 32) hist[tid] = 0u;
        __syncthreads();
        int e1 = 0, e2 = 0; float w1 = 0.f, w2 = 0.f; unsigned p1 = 0, p2 = 0; const int tok = chunk * 64 + tid;
        if (tid < 64) {
            const float* lg = logits + (size_t)tok * 256;
            float gl[4]; float gm = -3.0e38f; int gs = 0;
#pragma unroll
            for (int i = 0; i < 4; ++i) { gl[i] = lg[i] + bgp[i]; if (gl[i] > gm) { gm = gl[i]; gs = i; } }
            float gsum = 0.f;
#pragma unroll
            for (int i = 0; i < 4; ++i) gsum += __expf(gl[i] - gm);
            const float pg = 1.0f / gsum;
            float el[8]; float m1 = -3.0e38f; int s1 = 0;
#pragma unroll
            for (int i = 0; i < 8; ++i) { el[i] = lg[4 + gs * 8 + i] + brp[gs * 8 + i]; if (el[i] > m1) { m1 = el[i]; s1 = i; } }
            float m2 = -3.0e38f; int s2 = 0;
#pragma unroll
            for (int i = 0; i < 8; ++i) if (i != s1 && el[i] > m2) { m2 = el[i]; s2 = i; }
            const float x2 = __expf(m2 - m1), den = 1.0f / (1.0f + x2);
            w1 = pg * den; w2 = pg * x2 * den; e1 = gs * 8 + s1; e2 = gs * 8 + s2;
            p1 = __hip_atomic_fetch_add(hist + e1, 1u, __ATOMIC_RELAXED, __HIP_MEMORY_SCOPE_WORKGROUP);
            p2 = __hip_atomic_fetch_add(hist + e2, 1u, __ATOMIC_RELAXED, __HIP_MEMORY_SCOPE_WORKGROUP);
        }
        __syncthreads();
        if (tid < 32) { const unsigned hcount = hist[tid]; base[tid] = hcount ? __hip_atomic_fetch_add(cnt + tid, hcount, __ATOMIC_RELAXED, __HIP_MEMORY_SCOPE_AGENT) : 0u; }
        __syncthreads();
        if (tid < 64) { p1 += base[e1]; p2 += base[e2];
            rows[e1 * 16384 + (int)p1] = tok; rows[e2 * 16384 + (int)p2] = tok;
            float* ti = tokinfo + (size_t)tok * 8; ti[0] = __int_as_float(e1); ti[1] = __int_as_float((int)p1); ti[2] = w1; ti[3] = __int_as_float(e2); ti[4] = __int_as_float((int)p2); ti[5] = w2; }
    }
}
DI int moe_tables(LAS unsigned char* misc, const unsigned* cnt) {
    const int tid = threadIdx.x; LAS int* w = (LAS int*)misc;
    __syncthreads();
    if (tid < 32) w[16 + tid] = (int)cnt[tid];
    __syncthreads();
    if (tid == 0) { int acc = 0; for (int e = 0; e < 32; ++e) { w[48 + e] = acc; acc += (w[16 + e] + 255) >> 8; } w[80] = acc; }
    __syncthreads();
    const int ntot = w[80];
    for (int rt = tid; rt < ntot; rt += 512) { int e = 0;
        for (int k = 0; k < 32; ++k) if (w[48 + k] <= rt && rt < w[48 + k + 1]) e = k;
        const int loc = (rt - w[48 + e]) * 256; int nv = w[16 + e] - loc; nv = nv > 256 ? 256 : nv;
        w[128 + rt * 4] = e; w[128 + rt * 4 + 1] = e * 16384 + loc; w[128 + rt * 4 + 2] = nv; w[128 + rt * 4 + 3] = 0; }
    __syncthreads();
    return ntot;
}
DI void combine_phase(LAS unsigned char* misc, const float* tokinfo, const bf16_t* Y, float* xr, float* out, const float* gnext, bf16_t* h) {
    const int tid = threadIdx.x, wid = tid >> 6, lane = tid & 63; const LAS int* w = (const LAS int*)misc;
    for (int tok = blockIdx.x * 8 + wid; tok < NTOK; tok += gridDim.x * 8) {
        const float* ti = tokinfo + (size_t)tok * 8;
        const int e1 = __float_as_int(ti[0]), p1 = __float_as_int(ti[1]), e2 = __float_as_int(ti[3]), p2 = __float_as_int(ti[4]); const float w1 = ti[2], w2 = ti[5];
        const bf16_t* y1 = Y + ((size_t)w[48 + e1] * 256 + p1) * DM; const bf16_t* y2 = Y + ((size_t)w[48 + e2] * 256 + p2) * DM;
        float* xp = xr + (size_t)tok * DM; f32x4 v[8]; float ss = 0.f;
#pragma unroll
        for (int i = 0; i < 8; ++i) { const int col = i * 256 + lane * 4; const f32x4 x = *(const f32x4*)(xp + col); const u32x2 a = *(const u32x2*)(y1 + col), bq = *(const u32x2*)(y2 + col);
            v[i][0] = x[0] + (w1 * bflo(a[0]) + w2 * bflo(bq[0])); v[i][1] = x[1] + (w1 * bfhi(a[0]) + w2 * bfhi(bq[0]));
            v[i][2] = x[2] + (w1 * bflo(a[1]) + w2 * bflo(bq[1])); v[i][3] = x[3] + (w1 * bfhi(a[1]) + w2 * bfhi(bq[1]));
            ss += (v[i][0] * v[i][0] + v[i][1] * v[i][1]) + (v[i][2] * v[i][2] + v[i][3] * v[i][3]); }
        if (out) {
#pragma unroll
            for (int i = 0; i < 8; ++i) *(f32x4*)(out + (size_t)tok * DM + i * 256 + lane * 4) = v[i];
        } else {
            ss = wave_sum(ss); const float rs = __builtin_amdgcn_rsqf(ss * (1.0f / 2048.0f) + 1e-6f);
#pragma unroll
            for (int i = 0; i < 8; ++i) { const int col = i * 256 + lane * 4; *(f32x4*)(xp + col) = v[i]; const f32x4 gg = *(const f32x4*)(gnext + col);
                u32x2 wv = {cvtpk(v[i][0] * rs * gg[0], v[i][1] * rs * gg[1]), cvtpk(v[i][2] * rs * gg[2], v[i][3] * rs * gg[3])};
                *(u32x2*)(h + (size_t)tok * DM + col) = wv; }
        }
    }
}

constexpr int NPHASE = 20;
__global__ void __launch_bounds__(512, 2) fwd(Args a) {
    extern __shared__ __attribute__((aligned(16))) unsigned char shm[];
    LAS unsigned char* lds = (LAS unsigned char*)shm;
    LAS unsigned char* misc = lds + LDS_MISC;
    const int tid = threadIdx.x, G = gridDim.x, bx = blockIdx.x;
    unsigned char* ws = a.ws;
    if (tid < 4) ((LAS unsigned*)misc)[tid] = 0u;
    __syncthreads();
    const int lo = a.ph_lo, hi = a.ph_hi;
    XcdBarrier bar; bar.bar = (unsigned*)(ws + WS_BAR); bar.x = 0; bar.st = nullptr;
    if (hi - lo > 1) bar = xcd_barrier_post((unsigned*)(ws + WS_BAR), (volatile LAS unsigned*)misc);
#ifndef PHMASK
#define PHMASK 0xFFFFFu
#endif
#define IN(k) (((PHMASK >> (k)) & 1u) && lo <= (k) && (k) < hi)
#define SEAM(k) do { if (IN(k) && IN((k) + 1)) xcd_barrier(bar); } while (0)
    bf16_t* H = (bf16_t*)(ws + WS_H); bf16_t* PROJ = (bf16_t*)(ws + WS_PROJ); bf16_t* ATT = (bf16_t*)(ws + WS_ATT); float* XR = (float*)(ws + WS_XR);
    bf16_t* KCMP = (bf16_t*)(ws + WS_KCMP); bf16_t* VCMP = (bf16_t*)(ws + WS_VCMP);
    float* LOGITS = (float*)(ws + WS_PROJ); bf16_t* Y = (bf16_t*)(ws + WS_PROJ); bf16_t* ACT = (bf16_t*)(ws + WS_ATT);
    int* ROWS = (int*)(ws + WS_ROWS); float* TOK = (float*)(ws + WS_TOK);

    if (IN(0)) { phase_prologue(a, lds); } SEAM(0);
    if (IN(1)) { pg8::Gemm g{H, (const bf16_t*)(ws + WS_WIN0), DM}; pg8::StaticOrder S; S.init(NTOK, LDP0, G, bx); pg8::EpiBf16 E{PROJ, LDP0};
        pg8::gemm_phase(lds, g, S, E); } SEAM(1);
    if (IN(2)) { for (int it = bx; it < 256; it += G) cmp_item(lds, it, PROJ, (const bf16_t*)(ws + WS_CW1), (const bf16_t*)(ws + WS_CW2), (const float*)(ws + WS_BIAS1), a.in[4] + 128, KCMP, VCMP);
        knorm_phase(PROJ, a.in[4]); } SEAM(2);
    if (IN(3)) {
        { int s = 0; for (int it = bx; it < 1024; it += G, ++s) at::nsa_cmp_item((LAS char*)lds, it, s & 7, PROJ, KCMP, VCMP, a.in[4], ATT); }
        { int s = 0; for (int it = bx; it < 1024; it += G, ++s) at::nsa_slc_item((LAS char*)lds, it, s & 7, PROJ, a.in[4], ATT); }
        for (int it = bx; it < 1024; it += G) at::nsa_win_item((LAS char*)lds, it, PROJ, a.in[4], ATT);
    } SEAM(3);
    if (IN(4)) { pg8::Gemm g{ATT, (const bf16_t*)(ws + WS_WOUT0), DM}; pg8::StaticOrder S; S.init(NTOK, DM, G, bx); pg8::EpiF32 E{a.in[0], XR, DM};
        pg8::gemm_phase(lds, g, S, E); } SEAM(4);
#define MOE_LAYER(L, p0) do { \
        unsigned* cnt = (unsigned*)(ws + WS_CNT) + 32 * (L); \
        if (IN((p0))) { phase_norm(XR, a.in[2] + (L) * DM, H); } SEAM((p0)); \
        if (IN((p0) + 1)) { pg8::Gemm g{H, (const bf16_t*)(ws + WS_WR) + (size_t)(L) * 256 * DM, DM}; pg8::StaticOrder S; S.init(NTOK, 256, G, bx); pg8::EpiF32 E{nullptr, LOGITS, 256}; \
            pg8::gemm_phase(lds, g, S, E); } SEAM((p0) + 1); \
        if (IN((p0) + 2)) { route_phase(lds, LOGITS, a.in[12] + (L) * 4, a.in[14] + (L) * 32, cnt, ROWS, TOK); } SEAM((p0) + 2); \
        if (IN((p0) + 3)) { const int ntot = moe_tables(misc, cnt); \
            pg8::Gemm g{H, (const bf16_t*)(ws + WS_W1) + (size_t)(L) * 32 * 1024 * DM, DM}; \
            pg8::MoeOrder<true> S{ntot * 4, 4, G, bx, (const LAS int*)misc + 128, ROWS}; pg8::EpiSwiglu E{ACT}; \
            pg8::gemm_phase(lds, g, S, E); } SEAM((p0) + 3); \
        if (IN((p0) + 4)) { const int ntot = moe_tables(misc, cnt); \
            pg8::Gemm g{ACT, (const bf16_t*)(ws + WS_W2) + (size_t)(L) * 32 * DM * 512, DEXP}; \
            pg8::MoeOrder<false> S{ntot * 8, 8, G, bx, (const LAS int*)misc + 128, ROWS}; pg8::EpiBf16 E{Y, DM}; \
            pg8::gemm_phase(lds, g, S, E); } SEAM((p0) + 4); \
        if (IN((p0) + 5)) { (void)moe_tables(misc, cnt); \
            combine_phase(misc, TOK, Y, XR, (L) == 1 ? a.out : nullptr, a.in[1] + DM, H); } SEAM((p0) + 5); } while (0)
    MOE_LAYER(0, 5);
    if (IN(11)) { pg8::Gemm g{H, (const bf16_t*)(ws + WS_WIN1), DM}; pg8::StaticOrder S; S.init(NTOK, LDP1, G, bx); pg8::EpiBf16 E{PROJ, LDP1};
        pg8::gemm_phase(lds, g, S, E); } SEAM(11);
    if (IN(12)) { for (int it = bx; it < 1024; it += G) at::sb_item((LAS char*)lds, it, PROJ, ATT); } SEAM(12);
    if (IN(13)) { pg8::Gemm g{ATT, (const bf16_t*)(ws + WS_WOUT1), DM}; pg8::StaticOrder S; S.init(NTOK, DM, G, bx); pg8::EpiF32 E{XR, XR, DM};
        pg8::gemm_phase(lds, g, S, E); } SEAM(13);
    MOE_LAYER(1, 14);
#undef MOE_LAYER
#undef IN
#undef SEAM
}

extern "C" void kernel_launch(void* const* d_in, const int* in_sizes, int n_in, void* d_out, int out_size, void* d_ws, size_t ws_size, hipStream_t stream) {
    static int grid = 0;
    if (grid == 0) {
        if (n_in != 18 || out_size != NTOK * DM || ws_size < WS_END) { fprintf(stderr, "kernel_launch: unexpected shapes (n_in %d out %d ws %zu need %zu)\n", n_in, out_size, ws_size, (size_t)WS_END); grid = -1; return; }
        int dev = 0, cus = 0, per_cu = 0;
        if (hipGetDevice(&dev) != hipSuccess || hipDeviceGetAttribute(&cus, hipDeviceAttributeMultiprocessorCount, dev) != hipSuccess) { grid = -1; return; }
        if (hipFuncSetAttribute((const void*)fwd, hipFuncAttributeMaxDynamicSharedMemorySize, LDS_BYTES) != hipSuccess) { fprintf(stderr, "kernel_launch: hipFuncSetAttribute failed\n"); grid = -1; return; }
        if (hipOccupancyMaxActiveBlocksPerMultiprocessor(&per_cu, (const void*)fwd, 512, LDS_BYTES) != hipSuccess || per_cu < 1) { fprintf(stderr, "kernel_launch: occupancy query says %d\n", per_cu); }
        (void)hipGetLastError();
        grid = cus;
    }
    if (grid < 0) return;
    (void)hipMemsetAsync((char*)d_ws, 0, WS_ZERO_BYTES, stream);
    Args a{};
    for (int i = 0; i < 18; ++i) a.in[i] = (const float*)d_in[i];
    a.out = (float*)d_out; a.ws = (unsigned char*)d_ws;
#ifndef ONE_LAUNCH
#define ONE_LAUNCH 1
#endif
    if (ONE_LAUNCH) { a.ph_lo = 0; a.ph_hi = NPHASE; hipLaunchKernelGGL(fwd, dim3(grid), dim3(512), LDS_BYTES, stream, a); }
    else for (int p = 0; p < NPHASE; ++p) { a.ph_lo = p; a.ph_hi = p + 1; hipLaunchKernelGGL(fwd, dim3(grid), dim3(512), LDS_BYTES, stream, a); }
}
```

```cpp
#include <hip/hip_runtime.h>
#include <stdint.h>
#include <stdio.h>

#define LAS __attribute__((address_space(3)))
#define DI __device__ __forceinline__
typedef unsigned short bf16_t;
typedef short bf16x8 __attribute__((ext_vector_type(8)));
typedef short s16x4 __attribute__((ext_vector_type(4)));
typedef float f32x4 __attribute__((ext_vector_type(4)));
typedef float f32x2 __attribute__((ext_vector_type(2)));
typedef float f32x16 __attribute__((ext_vector_type(16)));
typedef unsigned u32x4 __attribute__((ext_vector_type(4)));
typedef unsigned u32x2 __attribute__((ext_vector_type(2)));

constexpr int T_ = 8192, B_ = 2, NTOK = B_ * T_, DM = 2048, HD = 128, NH = 16, NKV = 4;
constexpr int LDP0 = 5376;
constexpr int C_Q = 0, C_KC = 2048, C_VC = 2560, C_KS = 3072, C_VS = 3584, C_KW = 4096, C_VW = 4608, C_GT = 5120;
constexpr int LDP1 = 6144;
constexpr int NEXP = 32, DEXP = 512;
constexpr int MAXTILES = 160;
constexpr float LOG2E = 1.4426950408889634f;
constexpr float QSCALE = 0.08838834764831845f;

constexpr size_t WS_BAR   = 0;
constexpr size_t WS_CNT   = 16384;
constexpr size_t WS_ZERO_BYTES = 32768;
constexpr size_t WS_BIAS1 = 32768;
constexpr size_t WS_WIN0  = 1u << 20;
constexpr size_t WS_WOUT0 = WS_WIN0 + (size_t)LDP0 * DM * 2;
constexpr size_t WS_WIN1  = WS_WOUT0 + (size_t)DM * DM * 2;
constexpr size_t WS_WOUT1 = WS_WIN1 + (size_t)LDP1 * DM * 2;
constexpr size_t WS_WR    = WS_WOUT1 + (size_t)DM * DM * 2;
constexpr size_t WS_W1    = WS_WR + (size_t)2 * 256 * DM * 2;
constexpr size_t WS_W2    = WS_W1 + (size_t)2 * 32 * 1024 * DM * 2;
constexpr size_t WS_CW1   = WS_W2 + (size_t)2 * 32 * DM * 512 * 2;
constexpr size_t WS_CW2   = WS_CW1 + (size_t)2 * 128 * 4096 * 2;
constexpr size_t WS_H     = WS_CW2 + (size_t)2 * 128 * 128 * 2;
constexpr size_t WS_PROJ  = WS_H + (size_t)NTOK * DM * 2;
constexpr size_t WS_ATT   = WS_PROJ + (size_t)NTOK * LDP1 * 2;
constexpr size_t WS_XR    = WS_ATT + (size_t)NTOK * DM * 2;
constexpr size_t WS_KCMP  = WS_XR + (size_t)NTOK * DM * 4;
constexpr size_t WS_VCMP  = WS_KCMP + (size_t)2 * 4 * 512 * 128 * 2;
constexpr size_t WS_ROWS  = WS_VCMP + (size_t)2 * 4 * 512 * 128 * 2;
constexpr size_t WS_TOK   = WS_ROWS + (size_t)32 * 16384 * 4;
constexpr size_t WS_GATES = WS_TOK + (size_t)NTOK * 32;
constexpr size_t WS_Z     = WS_GATES + (size_t)NTOK * 48 * 4;
constexpr size_t WS_END   = WS_Z + (size_t)NTOK * DM * 2;

constexpr int LDS_STAGE = 131072;
constexpr int LDS_MISC  = 144384;
constexpr int LDS_BYTES = 144384 + 4096;

DI unsigned cvtpk(float lo, float hi) { unsigned r; asm volatile("v_cvt_pk_bf16_f32 %0, %1, %2" : "=v"(r) : "v"(lo), "v"(hi)); return r; }
DI float bflo(unsigned w) { return __uint_as_float(w << 16); }
DI float bfhi(unsigned w) { return __uint_as_float(w & 0xffff0000u); }
DI float wave_sum(float v) { for (int o = 32; o >= 1; o >>= 1) v += __shfl_xor(v, o); return v; }
DI bf16x8 pack8(f32x4 a, f32x4 b) { u32x4 w = {cvtpk(a[0], a[1]), cvtpk(a[2], a[3]), cvtpk(b[0], b[1]), cvtpk(b[2], b[3])}; return __builtin_bit_cast(bf16x8, w); }

#define XB_TMO      128
#define XB_XCNT(j)  (256  + 64 * (j))
#define XB_XSUB(j)  (1280 + 64 * (j))
#define XB_XGEN(j)  (2304 + 64 * (j))
#define XB_TOP      3328
#define XB_TOPGEN   3392
#define XCD_BAR_WORDS 3456
#define XB_SPIN_CAP (1u << 18)
__device__ __forceinline__ unsigned xb_ld(unsigned* p)              { return __hip_atomic_load(p, __ATOMIC_RELAXED, __HIP_MEMORY_SCOPE_AGENT); }
__device__ __forceinline__ unsigned xb_add(unsigned* p, unsigned v) { return __hip_atomic_fetch_add(p, v, __ATOMIC_RELAXED, __HIP_MEMORY_SCOPE_AGENT); }
__device__ __forceinline__ unsigned xb_xcc_id() { return (unsigned)__builtin_amdgcn_s_getreg((3 << 11) | 20) & 0xFu; }
#define XB_SPIN(cond, bar) do { unsigned _sp = 0; while (cond) { __builtin_amdgcn_s_sleep(1); \
    if ((++_sp & 255u) == 0u) { if (xb_ld(&(bar)[XB_TMO])) break; if (_sp > XB_SPIN_CAP) { atomicAdd(&(bar)[XB_TMO], 1u); break; } } } } while (0)
struct XcdBarrier { unsigned* bar; unsigned x; volatile LAS unsigned* st; };
__device__ __forceinline__ XcdBarrier xcd_barrier_post(unsigned* bar, volatile LAS unsigned* st) {
    XcdBarrier b; b.bar = bar; b.x = xb_xcc_id(); b.st = st;
    if (threadIdx.x == 0) (void)xb_add(&bar[XB_XCNT(b.x)], 1u);
    return b;
}
__device__ __forceinline__ void xcd_barrier_complete(unsigned* bar, unsigned x, unsigned& nloc, unsigned& nx) {
    const unsigned G = gridDim.x * gridDim.y * gridDim.z;
    unsigned sum, cnt, mine, sp = 0u;
    for (;;) {
        sum = 0u; cnt = 0u; mine = 0u;
#pragma unroll
        for (unsigned j = 0; j < 16; ++j) { const unsigned c = xb_ld(&bar[XB_XCNT(j)]); sum += c; cnt += (c > 0u) ? 1u : 0u; mine = (j == x) ? c : mine; }
        if (sum == G) break;
        __builtin_amdgcn_s_sleep(1);
        if ((++sp & 255u) == 0u) { if (xb_ld(&bar[XB_TMO])) break; if (sp > XB_SPIN_CAP) { atomicAdd(&bar[XB_TMO], 1u); break; } }
    }
    nloc = mine > 0u ? mine : 1u; nx = cnt > 0u ? cnt : 1u;
}
__device__ __forceinline__ void xcd_barrier(const XcdBarrier& b) {
    asm volatile("s_waitcnt vmcnt(0)" ::: "memory");
    __syncthreads();
    if (threadIdx.x == 0) {
        unsigned* bar = b.bar;
        __builtin_amdgcn_s_waitcnt(0);
        unsigned nloc = b.st[0], nx = b.st[1];
        if (nloc == 0u) { xcd_barrier_complete(bar, b.x, nloc, nx); b.st[0] = nloc; b.st[1] = nx; }
        const unsigned old = xb_add(&bar[XB_XSUB(b.x)], 1u);
        const unsigned gen = old / nloc;
        if (old + 1u == (gen + 1u) * nloc) {
            __builtin_amdgcn_fence(__ATOMIC_RELEASE, "agent");
            asm volatile("s_waitcnt vmcnt(0)" ::: "memory");
            const unsigned og = xb_add(&bar[XB_TOP], 1u);
            const unsigned tg = og / nx;
            if (og + 1u == (tg + 1u) * nx) xb_add(&bar[XB_TOPGEN], 1u);
            else XB_SPIN(xb_ld(&bar[XB_TOPGEN]) == tg, bar);
            __builtin_amdgcn_fence(__ATOMIC_ACQUIRE, "agent");
            xb_add(&bar[XB_XGEN(b.x)], 1u);
            asm volatile("s_waitcnt vmcnt(0)" ::: "memory");
        } else {
            XB_SPIN(xb_ld(&bar[XB_XGEN(b.x)]) == gen, bar);
            __builtin_amdgcn_fence(__ATOMIC_ACQUIRE, "agent");
            asm volatile("s_waitcnt vmcnt(0)" ::: "memory");
        }
    }
    __syncthreads();
}

namespace pg8 {
constexpr int BM = 256, BK = 64, HALF = 128, HTB = HALF * BK * 2, STAGE_BYTES = 8 * HTB, NXCD = 8, WGM = 8;
DI int lds_byte(int r, int c) { const int st = (r >> 4) * 2 + (c >> 5), rr = r & 15, cc = c & 31, ob = rr * 64 + cc * 2; return st * 1024 + (ob ^ (((ob >> 9) & 1) << 5)); }
DI void stage_rc(int b, int& R, int& C) { const int st = b / 1024, sb = b % 1024, swz = sb ^ (((sb >> 9) & 1) << 5); R = (st >> 1) * 16 + swz / 64; C = (st & 1) * 32 + (swz % 64) / 2; }
DI int perm32(int rho) { const int n = rho >> 4, i = rho & 15; return 8 * (i >> 2) + 4 * n + (i & 3); }
struct Unit { int pm, pn, pb; };
struct Gemm { const bf16_t* A; const bf16_t* Bt; int K; };

struct StaticOrder {
    int nM, nN, nwg, G, c;
    DI void init(int M, int N, int G_, int c_) { nM = M / BM; nN = N / BM; nwg = nM * nN; G = G_; c = c_; }
    DI bool next(int i, Unit& u) const {
        const long L = (long)i * G + c; if (L >= nwg) return false;
        int wgid = (int)L; { const int q = nwg / NXCD, r = nwg % NXCD, xcd = wgid % NXCD, off = wgid / NXCD; wgid = (xcd < r ? xcd * (q + 1) : r * (q + 1) + (xcd - r) * q) + off; }
        const int nig = WGM * nN, gid = wgid / nig, fm = gid * WGM, gsz = (nM - fm) < WGM ? (nM - fm) : WGM;
        u.pm = fm + ((wgid % nig) % gsz); u.pn = (wgid % nig) / gsz; u.pb = u.pn; return true;
    }
    DI int arow(const Unit& u, int r) const { return u.pm * BM + r; }
};
template <bool GATHER> struct MoeOrder {
    int ntot, nct, G, c; const LAS int* tinfo; const int* rows;
    DI bool next(int i, Unit& u) const {
        const int L = i * G + c; if (L >= ntot) return false;
        const int rt = L / nct, pn = L - rt * nct; u.pm = rt; u.pn = pn; u.pb = tinfo[rt * 4] * nct + pn; return true;
    }
    DI int arow(const Unit& u, int r) const {
        if constexpr (GATHER) { const int base = tinfo[u.pm * 4 + 1], nv = tinfo[u.pm * 4 + 2]; return r < nv ? rows[base + r] : 0; }
        else return u.pm * BM + r;
    }
};

struct EpiBf16 {
    static constexpr bool PERM = true;
    bf16_t* O; int ldc;
    DI void operator()(const f32x4 (&acc)[2][2][4][2], const Unit& u, int wr, int wc, int fr, int fq) const {
        const int row0 = u.pm * BM + wr * 64 + fr, col0 = u.pn * BM + wc * 32 + 8 * fq;
#pragma unroll
        for (int ai = 0; ai < 2; ++ai)
#pragma unroll
            for (int m = 0; m < 4; ++m) { bf16_t* rowp = O + (size_t)(row0 + ai * HALF + m * 16) * ldc + col0;
#pragma unroll
                for (int bj = 0; bj < 2; ++bj) { const f32x4 v0 = acc[ai][bj][m][0], v1 = acc[ai][bj][m][1];
                    u32x4 w; w.x = cvtpk(v0[0], v0[1]); w.y = cvtpk(v0[2], v0[3]); w.z = cvtpk(v1[0], v1[1]); w.w = cvtpk(v1[2], v1[3]);
                    *(u32x4*)(rowp + bj * HALF) = w; } }
    }
};
struct EpiF32 {
    static constexpr bool PERM = false;
    const float* base; float* C; int ldc;
    DI void operator()(const f32x4 (&acc)[2][2][4][2], const Unit& u, int wr, int wc, int fr, int fq) const {
        const int row0 = u.pm * BM + wr * 64 + fr, col0 = u.pn * BM + wc * 32 + 4 * fq;
#pragma unroll
        for (int ai = 0; ai < 2; ++ai)
#pragma unroll
            for (int m = 0; m < 4; ++m) { const size_t off = (size_t)(row0 + ai * HALF + m * 16) * ldc + col0;
#pragma unroll
                for (int bj = 0; bj < 2; ++bj)
#pragma unroll
                    for (int n = 0; n < 2; ++n) { f32x4 v = acc[ai][bj][m][n]; if (base) v += *(const f32x4*)(base + off + bj * HALF + n * 16);
                        *(f32x4*)(C + off + bj * HALF + n * 16) = v; } }
    }
};
struct EpiSwiglu {
    static constexpr bool PERM = true;
    bf16_t* O;
    DI void operator()(const f32x4 (&acc)[2][2][4][2], const Unit& u, int wr, int wc, int fr, int fq) const {
        const int row0 = u.pm * BM + wr * 64 + fr, col0 = u.pn * HALF + wc * 32 + 8 * fq;
#pragma unroll
        for (int ai = 0; ai < 2; ++ai)
#pragma unroll
            for (int m = 0; m < 4; ++m) { bf16_t* rowp = O + (size_t)(row0 + ai * HALF + m * 16) * DEXP + col0;
                float h[8];
#pragma unroll
                for (int n = 0; n < 2; ++n)
#pragma unroll
                    for (int j = 0; j < 4; ++j) { const float gt = acc[ai][0][m][n][j], up = acc[ai][1][m][n][j];
                        h[n * 4 + j] = gt * __builtin_amdgcn_rcpf(1.0f + __builtin_amdgcn_exp2f(-gt * LOG2E)) * up; }
                u32x4 w; w.x = cvtpk(h[0], h[1]); w.y = cvtpk(h[2], h[3]); w.z = cvtpk(h[4], h[5]); w.w = cvtpk(h[6], h[7]);
                *(u32x4*)rowp = w; }
    }
};

template <class Epi, class Sched>
DI void gemm_phase(LAS unsigned char* lds, const Gemm g, const Sched& S, const Epi& E) {
    const int tid = threadIdx.x, wid = __builtin_amdgcn_readfirstlane(tid >> 6), lane = tid & 63, wr = wid >> 2, wc = wid & 3, fr = lane & 15, fq = lane >> 4;
    const int K = g.K, nt = K / BK;
    int Ra[2]; unsigned Ca[2], voffB[2];
#pragma unroll
    for (int i = 0; i < 2; ++i) { int R, C; stage_rc(tid * 16 + i * 8192, R, C); const int Rb = Epi::PERM ? ((R & ~31) + perm32(R & 31)) : R;
        Ra[i] = R; Ca[i] = (unsigned)C * 2u; voffB[i] = (unsigned)(Rb * K + C) * 2u; }
    const unsigned rowB = (unsigned)K * 2u;
    const size_t kstep = (size_t)(BK * 2);
    const size_t hstep = (size_t)HALF * K * 2;
    const size_t tstep = 2 * hstep;
    const unsigned ldsw = (unsigned)wid * 1024u;
    const int aoff = lds_byte(wr * 64 + fr, fq * 8), boff = lds_byte(wc * 32 + fr, fq * 8);
#define PG8_SA(b, h) (((b) * 2 + (h)) * HTB)
#define PG8_SB(b, h) ((4 + (b) * 2 + (h)) * HTB)
#define PG8_STAGE(bufoff, gbase, voff) do { _Pragma("unroll") for (int _i = 0; _i < 2; ++_i) \
        __builtin_amdgcn_global_load_lds((const unsigned*)((const char*)(gbase) + (voff)[_i]), (LAS unsigned*)(lds + (bufoff) + ldsw + _i * 8192), 16, 0, 0); } while (0)
#define PG8_LDA(dst, b, h) do { _Pragma("unroll") for (int m = 0; m < 4; ++m) _Pragma("unroll") for (int k = 0; k < 2; ++k) dst[m][k] = *(const LAS bf16x8*)(lds + PG8_SA(b, h) + aoff + m * 2048 + k * 1024); } while (0)
#define PG8_LDB(dst, b, h) do { _Pragma("unroll") for (int n = 0; n < 2; ++n) _Pragma("unroll") for (int k = 0; k < 2; ++k) dst[n][k] = *(const LAS bf16x8*)(lds + PG8_SB(b, h) + boff + n * 2048 + k * 1024); } while (0)
#define PG8_MMA(ai, bj, At, Bt) do { __builtin_amdgcn_s_setprio(1); _Pragma("unroll") for (int m = 0; m < 4; ++m) _Pragma("unroll") for (int n = 0; n < 2; ++n) _Pragma("unroll") for (int k = 0; k < 2; ++k) \
        acc[ai][bj][m][n] = __builtin_amdgcn_mfma_f32_16x16x32_bf16(Bt[n][k], At[m][k], acc[ai][bj][m][n], 0, 0, 0); __builtin_amdgcn_s_setprio(0); } while (0)
#define PG8_WAIT_V(n) asm volatile("s_waitcnt vmcnt(" #n ")" ::: "memory")
#define PG8_WAIT_L(n) asm volatile("s_waitcnt lgkmcnt(" #n ")" ::: "memory")
#define PG8_BAR __builtin_amdgcn_s_barrier()
#define PG8_SCHED __builtin_amdgcn_sched_barrier(0)
#define PG8_MKVA(dst, u) do { _Pragma("unroll") for (int _h = 0; _h < 2; ++_h) _Pragma("unroll") for (int _i = 0; _i < 2; ++_i) \
        dst[_h][_i] = (unsigned)S.arow(u, _h * HALF + Ra[_i]) * rowB + Ca[_i]; } while (0)
    Unit cur, nxt; int ui = 0;
    if (!S.next(0, cur)) return;
    f32x4 acc[2][2][4][2];
#pragma unroll
    for (int a = 0; a < 2; ++a)
#pragma unroll
        for (int b = 0; b < 2; ++b)
#pragma unroll
            for (int m = 0; m < 4; ++m)
#pragma unroll
                for (int n = 0; n < 2; ++n) acc[a][b][m][n] = (f32x4){0.f, 0.f, 0.f, 0.f};
    bf16x8 At[4][2], B0[2][2], B1[2][2];
    const char* Ab = (const char*)g.A;
    unsigned va[2][2], nva[2][2];
    PG8_MKVA(va, cur);
    const char* cB = (const char*)g.Bt + (size_t)cur.pb * tstep;
    PG8_STAGE(PG8_SB(0, 0), cB, voffB); PG8_STAGE(PG8_SA(0, 0), Ab, va[0]); PG8_STAGE(PG8_SB(0, 1), cB + hstep, voffB); PG8_STAGE(PG8_SA(0, 1), Ab, va[1]);
    if (wr == 1) PG8_BAR;
    PG8_WAIT_V(4); PG8_BAR;
    PG8_STAGE(PG8_SB(1, 0), cB + kstep, voffB); PG8_STAGE(PG8_SA(1, 0), Ab + kstep, va[0]); PG8_STAGE(PG8_SB(1, 1), cB + hstep + kstep, voffB);
    PG8_WAIT_V(6); PG8_BAR;
    for (;;) {
        const bool has_next = S.next(ui + 1, nxt);
        if (has_next) { PG8_MKVA(nva, nxt); } else {
#pragma unroll
            for (int h = 0; h < 2; ++h)
#pragma unroll
                for (int i = 0; i < 2; ++i) nva[h][i] = va[h][i]; }
        const char* nB = has_next ? (const char*)g.Bt + (size_t)nxt.pb * tstep : cB;
        for (int t = 0; t < nt; t += 2) {
            const bool last = (t == nt - 2);
            const char* a1 = Ab + (size_t)(t + 1) * kstep;
            const char* a2 = last ? Ab : Ab + (size_t)(t + 2) * kstep; const char* b2 = last ? nB : cB + (size_t)(t + 2) * kstep;
            const char* a3 = a2 + kstep; const char* b3 = b2 + kstep;
            unsigned xa[2][2];
#pragma unroll
            for (int h = 0; h < 2; ++h)
#pragma unroll
                for (int i = 0; i < 2; ++i) xa[h][i] = last ? nva[h][i] : va[h][i];
            PG8_LDB(B0, 0, 0); PG8_SCHED; PG8_LDA(At, 0, 0); PG8_STAGE(PG8_SA(1, 1), a1, va[1]);
            PG8_WAIT_L(8); PG8_BAR; PG8_WAIT_L(0); PG8_MMA(0, 0, At, B0); PG8_BAR; PG8_SCHED;
            PG8_LDB(B1, 0, 1); PG8_STAGE(PG8_SB(0, 0), b2, voffB);
            PG8_BAR; PG8_WAIT_L(0); PG8_MMA(0, 1, At, B1); PG8_BAR;
            PG8_LDA(At, 0, 1); PG8_STAGE(PG8_SA(0, 0), a2, xa[0]);
            PG8_BAR; PG8_WAIT_L(0); PG8_MMA(1, 0, At, B0); PG8_BAR; PG8_SCHED;
            PG8_STAGE(PG8_SB(0, 1), b2 + hstep, voffB);
            PG8_WAIT_V(6); PG8_BAR; PG8_MMA(1, 1, At, B1); PG8_BAR;
            PG8_LDB(B0, 1, 0); PG8_SCHED; PG8_LDA(At, 1, 0); PG8_STAGE(PG8_SA(0, 1), a2, xa[1]);
            PG8_WAIT_L(8); PG8_BAR; PG8_WAIT_L(0); PG8_MMA(0, 0, At, B0); PG8_BAR; PG8_SCHED;
            PG8_LDB(B1, 1, 1); PG8_STAGE(PG8_SB(1, 0), b3, voffB);
            PG8_BAR; PG8_WAIT_L(0); PG8_MMA(0, 1, At, B1); PG8_BAR;
            PG8_LDA(At, 1, 1); PG8_STAGE(PG8_SA(1, 0), a3, xa[0]);
            PG8_BAR; PG8_WAIT_L(0); PG8_MMA(1, 0, At, B0); PG8_BAR; PG8_SCHED;
            PG8_STAGE(PG8_SB(1, 1), b3 + hstep, voffB);
            PG8_WAIT_V(6); PG8_BAR; PG8_MMA(1, 1, At, B1); PG8_BAR;
        }
        E(acc, cur, wr, wc, fr, fq);
        if (!has_next) break;
#pragma unroll
        for (int a = 0; a < 2; ++a)
#pragma unroll
            for (int b = 0; b < 2; ++b)
#pragma unroll
                for (int m = 0; m < 4; ++m)
#pragma unroll
                    for (int n = 0; n < 2; ++n) acc[a][b][m][n] = (f32x4){0.f, 0.f, 0.f, 0.f};
        cur = nxt; cB = nB; ++ui;
#pragma unroll
        for (int h = 0; h < 2; ++h)
#pragma unroll
            for (int i = 0; i < 2; ++i) va[h][i] = nva[h][i];
    }
    PG8_WAIT_V(0);
    if (wr == 0) PG8_BAR;
    PG8_BAR;
#undef PG8_SA
#undef PG8_SB
#undef PG8_STAGE
#undef PG8_LDA
#undef PG8_LDB
#undef PG8_MMA
#undef PG8_WAIT_V
#undef PG8_WAIT_L
#undef PG8_BAR
#undef PG8_SCHED
#undef PG8_MKVA
}
}

namespace at {
constexpr int SHM = 16384;
constexpr int STG_W = 32 * 272;
constexpr int L_K = 0, L_V = 2 * SHM, L_STG = 4 * SHM, L_WS = L_STG + 8 * STG_W, L_SEL = L_WS + 8 * 512, L_UNI = L_SEL + 1024, L_FLAG = L_UNI + 64;
static_assert(L_FLAG + 128 <= LDS_MISC, "attention LDS map");
#define KSWZ(row, colB) ((row) * 256 + ((colB) ^ (((row) & 7) << 4)))
#define SBAR() __builtin_amdgcn_sched_barrier(0)
DI int v_st(int k, int c) { const int kk = (k & ~0xC) | ((k & 4) << 1) | ((k & 8) >> 1); return ((kk >> 3) * 4 + (c >> 5)) * 512 + ((kk & 7) * 32 + (c & 31)) * 2; }
DI int v_rd_base(int lane) { return ((lane & 3) << 3) | (((lane >> 2) & 3) << 6) | (((lane >> 4) & 1) << 5) | (((lane >> 5) & 1) << 8); }
constexpr int v_rd_off(int d0, int ks, int half) { return d0 * 512 + ks * 4096 + half * 2048; }
DI int crow(int r, int hi) { return (r & 3) + 8 * (r >> 2) + 4 * hi; }

DI void qkt(f32x16& p0, f32x16& p1, const LAS char* K_lds, int r32, int hi, const bf16x8* qr) {
    p0 = f32x16{}; p1 = f32x16{};
    const LAS char* kb[4];
#pragma unroll
    for (int dd = 0; dd < 4; ++dd) kb[dd] = K_lds + KSWZ(r32, (dd * 16 + hi * 8) * 2);
#pragma unroll
    for (int d0 = 0; d0 < 8; ++d0) { const LAS char* a = kb[d0 & 3] + (d0 >> 2) * 128;
        const bf16x8 b0 = *(const LAS bf16x8*)a;
        const bf16x8 b1 = *(const LAS bf16x8*)(a + 32 * 256);
        p0 = __builtin_amdgcn_mfma_f32_32x32x16_bf16(b0, qr[d0], p0, 0, 0, 0);
        p1 = __builtin_amdgcn_mfma_f32_32x32x16_bf16(b1, qr[d0], p1, 0, 0, 0); }
}
DI void pv_tile(f32x16* o, int vb0, bf16x8 pa0, bf16x8 pa1, bf16x8 pa2, bf16x8 pa3) {
#define TRRD(dst, off) asm volatile("ds_read_b64_tr_b16 %0, %1 offset:%2" : "=&v"(dst) : "v"(vb0), "i"(off) : "memory")
#define PV_D0(d0) do { s16x4 l0, l1, l2, l3, h0, h1, h2, h3; constexpr int b_ = v_rd_off(d0, 0, 0); \
        TRRD(l0, b_); TRRD(h0, b_ + 2048); TRRD(l1, b_ + 4096); TRRD(h1, b_ + 6144); TRRD(l2, b_ + 8192); TRRD(h2, b_ + 10240); TRRD(l3, b_ + 12288); TRRD(h3, b_ + 14336); \
        asm volatile("s_waitcnt lgkmcnt(0)" ::: "memory"); SBAR(); \
        o[d0] = __builtin_amdgcn_mfma_f32_32x32x16_bf16(pa0, (bf16x8){l0[0], l0[1], l0[2], l0[3], h0[0], h0[1], h0[2], h0[3]}, o[d0], 0, 0, 0); \
        o[d0] = __builtin_amdgcn_mfma_f32_32x32x16_bf16(pa1, (bf16x8){l1[0], l1[1], l1[2], l1[3], h1[0], h1[1], h1[2], h1[3]}, o[d0], 0, 0, 0); \
        o[d0] = __builtin_amdgcn_mfma_f32_32x32x16_bf16(pa2, (bf16x8){l2[0], l2[1], l2[2], l2[3], h2[0], h2[1], h2[2], h2[3]}, o[d0], 0, 0, 0); \
        o[d0] = __builtin_amdgcn_mfma_f32_32x32x16_bf16(pa3, (bf16x8){l3[0], l3[1], l3[2], l3[3], h3[0], h3[1], h3[2], h3[3]}, o[d0], 0, 0, 0); } while (0)
    PV_D0(0); PV_D0(1); PV_D0(2); PV_D0(3);
#undef PV_D0
#undef TRRD
}
DI void pack_p(const f32x16& p0, const f32x16& p1, bf16x8& pa0, bf16x8& pa1, bf16x8& pa2, bf16x8& pa3) {
#define PK4(P, B_, OUT) do { unsigned a0 = cvtpk(P[B_+0], P[B_+1]), a1 = cvtpk(P[B_+2], P[B_+3]); \
        unsigned b0 = cvtpk(P[B_+4], P[B_+5]), b1 = cvtpk(P[B_+6], P[B_+7]); \
        auto r0 = __builtin_amdgcn_permlane32_swap(a0, b0, false, false); auto r1 = __builtin_amdgcn_permlane32_swap(a1, b1, false, false); \
        u32x4 w = {r0[0], r1[0], r0[1], r1[1]}; OUT = __builtin_bit_cast(bf16x8, w); } while (0)
    PK4(p0, 0, pa0); PK4(p0, 8, pa1); PK4(p1, 0, pa2); PK4(p1, 8, pa3);
#undef PK4
}
DI float half_max(float v) { auto rr = __builtin_amdgcn_permlane32_swap(__float_as_uint(v), __float_as_uint(v), false, false); return fmaxf(__uint_as_float(rr[0]), __uint_as_float(rr[1])); }
DI float half_sum(float v) { auto rr = __builtin_amdgcn_permlane32_swap(__float_as_uint(v), __float_as_uint(v), false, false); return __uint_as_float(rr[0]) + __uint_as_float(rr[1]); }

#define DPP_U32(x, ctrl) ((unsigned)__builtin_amdgcn_update_dpp((int)(x), (int)(x), (ctrl), 0xF, 0xF, false))
DI unsigned wave_max_u32(unsigned x) {
    unsigned y;
    y = DPP_U32(x, 0xB1); x = x > y ? x : y;
    y = DPP_U32(x, 0x4E); x = x > y ? x : y;
    y = DPP_U32(x, 0x141); x = x > y ? x : y;
    y = DPP_U32(x, 0x140); x = x > y ? x : y;
    { auto r = __builtin_amdgcn_permlane16_swap(x, x, false, false); x = r[0] > r[1] ? r[0] : r[1]; }
    { auto r = __builtin_amdgcn_permlane32_swap(x, x, false, false); x = r[0] > r[1] ? r[0] : r[1]; }
    return x;
}
DI float quad_sum(float v) {
    v += __uint_as_float(DPP_U32(__float_as_uint(v), 0xB1));
    v += __uint_as_float(DPP_U32(__float_as_uint(v), 0x4E));
    return v;
}
DI float partner32(float v, int hi) { auto rr = __builtin_amdgcn_permlane32_swap(__float_as_uint(v), __float_as_uint(v), false, false); return __uint_as_float(hi ? rr[0] : rr[1]); }

enum { M_CMP1 = 0, M_CMP2 = 1, M_SLC = 2, M_WIN = 3 };

struct NsaCtx {
    LAS char* lds; int tid, wid, lane, r32, hi, sr, sc, vb0;
    int b, g, t0, t;
    float slope2;
    const bf16_t* proj; const bf16_t* kcmp; const bf16_t* vcmp; const float* gates;
    unsigned sel0, sel1, sel2, sel3;
};

DI void dma_src_k(int P, int& row, int& col) { row = P >> 8; col = ((((P & 255) >> 4) ^ (row & 7)) << 3); }
DI void dma_src_v(int P, int& row, int& col) { const int st = P >> 9, wi = (P & 511) >> 1, kk = (st >> 2) * 8 + (wi >> 5); row = (kk & ~0xC) | ((kk & 4) << 1) | ((kk & 8) >> 1); col = (st & 3) * 32 + (wi & 31); }
struct DmaOff { unsigned ko[2], vo[2]; };
DI void dma_init(DmaOff& D, int wid, int lane, int pitch) {
#pragma unroll
    for (int i = 0; i < 2; ++i) { int r_, c_; dma_src_k(i * 8192 + wid * 1024 + lane * 16, r_, c_); D.ko[i] = (unsigned)(r_ * pitch + c_); dma_src_v(i * 8192 + wid * 1024 + lane * 16, r_, c_); D.vo[i] = (unsigned)(r_ * pitch + c_); }
}
template <bool NEEDV> DI void dma_tile(LAS char* lds, const DmaOff& D, const bf16_t* kt, const bf16_t* vt, int buf, int wid) {
#pragma unroll
    for (int i = 0; i < 2; ++i) {
        __builtin_amdgcn_global_load_lds((const unsigned*)(kt + D.ko[i]), (LAS unsigned*)(lds + L_K + buf * SHM + i * 8192 + wid * 1024), 16, 0, 0);
        if (NEEDV) __builtin_amdgcn_global_load_lds((const unsigned*)(vt + D.vo[i]), (LAS unsigned*)(lds + L_V + buf * SHM + i * 8192 + wid * 1024), 16, 0, 0); }
}
template <int NLD> DI void dma_wait(bool newest_in_flight) {
    if (newest_in_flight) { if (NLD == 4) asm volatile("s_waitcnt vmcnt(4)" ::: "memory"); else asm volatile("s_waitcnt vmcnt(2)" ::: "memory"); }
    else asm volatile("s_waitcnt vmcnt(0)" ::: "memory");
}

template <int MODE, bool PRE = false>
DI void nsa_pass(const NsaCtx& c, const bf16x8* qr, f32x16* o, float& m_reg, float& l_reg, float inv_l, int nt_or_jlo, int jhi, const unsigned* uni) {
    constexpr bool NEEDV = (MODE != M_CMP1), CMP = (MODE == M_CMP1 || MODE == M_CMP2); constexpr int NLD = NEEDV ? 4 : 2;
    const size_t rowbase = (size_t)c.b * T_;
    const bf16_t* Kb; const bf16_t* Vb; const int pitch = CMP ? 128 : LDP0;
    if (CMP) { Kb = c.kcmp + (size_t)(c.b * 4 + c.g) * 512 * 128; Vb = c.vcmp + (size_t)(c.b * 4 + c.g) * 512 * 128; }
    else if (MODE == M_SLC) { Kb = c.proj + rowbase * LDP0 + C_KS + c.g * 128; Vb = c.proj + rowbase * LDP0 + C_VS + c.g * 128; }
    else { Kb = c.proj + rowbase * LDP0 + C_KW + c.g * 128; Vb = c.proj + rowbase * LDP0 + C_VW + c.g * 128; }
    LAS float* ws = (LAS float*)(c.lds + L_WS) + c.wid * 128;
    LAS float* imp = (LAS float*)(c.lds + L_STG + c.wid * STG_W);
    DmaOff D; dma_init(D, c.wid, c.lane, pitch);
    const float s32 = 32.f * c.slope2, s64 = 64.f * c.slope2, hb = 4.f * (float)c.hi * c.slope2;
    const int twmin = c.t0 + c.wid * 8, twmax = twmin + 7, jd = c.t0 >> 6;
    unsigned u0 = 0, u1 = 0, u2 = 0, u3 = 0; int jw = CMP ? 0 : jhi;
    if (MODE == M_SLC) { u0 = uni[0]; u1 = uni[1]; u2 = uni[2]; u3 = uni[3]; }
    unsigned sl0 = c.sel0, sl1 = c.sel1, sl2 = c.sel2, sl3 = c.sel3; asm volatile("" : "+v"(sl0), "+v"(sl1), "+v"(sl2), "+v"(sl3));
#define NEXT_T(jj, hv) do { if (MODE == M_SLC) { \
            if (u3) { const int b_ = 31 - __builtin_clz(u3); jj = 96 + b_; u3 &= ~(1u << b_); hv = true; } else if (u2) { const int b_ = 31 - __builtin_clz(u2); jj = 64 + b_; u2 &= ~(1u << b_); hv = true; } \
            else if (u1) { const int b_ = 31 - __builtin_clz(u1); jj = 32 + b_; u1 &= ~(1u << b_); hv = true; } else if (u0) { const int b_ = 31 - __builtin_clz(u0); jj = b_; u0 &= ~(1u << b_); hv = true; } else hv = false; } \
        else if (CMP) { jj = jw; hv = jw < nt_or_jlo; ++jw; } \
        else { jj = jw; hv = jw >= nt_or_jlo; --jw; } } while (0)
#define SELBIT(jj) ((((jj) < 32 ? sl0 : (jj) < 64 ? sl1 : (jj) < 96 ? sl2 : sl3) >> ((jj) & 31)) & 1u)
    int j0 = 0, j1 = 0; bool h0, h1;
    NEXT_T(j0, h0); NEXT_T(j1, h1);
    if (!PRE) {
        __syncthreads();
        if (h0) dma_tile<NEEDV>(c.lds, D, Kb + (size_t)j0 * 64 * pitch, Vb + (size_t)j0 * 64 * pitch, 0, c.wid);
    }
    asm volatile("s_waitcnt vmcnt(0)" ::: "memory");
    __syncthreads();
    float prev_cy = 0.f;
    int cur = 0, jprev = j0;
    while (h0) {
        if (h1) dma_tile<NEEDV>(c.lds, D, Kb + (size_t)j1 * 64 * pitch, Vb + (size_t)j1 * 64 * pitch, cur ^ 1, c.wid);
        const int j = j0;
        bool act;
        if (CMP) act = (j * 1024 + 31) <= twmax;
        else if (MODE == M_SLC) act = __any(SELBIT(j) != 0u);
        else act = true;
        if (act) {
            f32x16 p0, p1;
            qkt(p0, p1, c.lds + L_K + cur * SHM, c.r32, c.hi, qr);
            const float NEG = -__builtin_inff();
            if (CMP) {
                const int dq = c.t - 31 - 1024 * j - 64 * c.hi; const float base = -c.slope2 * (float)dq, s16 = c.slope2 * 16.f;
#pragma unroll
                for (int r = 0; r < 16; ++r) { const int cc = (r & 3) + 8 * (r >> 2);
                    p0[r] = (dq - 16 * cc >= 0) ? fmaf(s16, (float)cc, p0[r] + base) : NEG;
                    p1[r] = (dq - 16 * cc - 512 >= 0) ? fmaf(s16, (float)(cc + 32), p1[r] + base) : NEG; }
            } else {
                m_reg += s64 * (float)(jprev - j); jprev = j;
#pragma unroll
                for (int r = 0; r < 16; ++r) { const float cc = (float)((r & 3) + 8 * (r >> 2)); p0[r] = fmaf(c.slope2, cc, p0[r]); p1[r] = fmaf(c.slope2, cc, p1[r]); }
                if (MODE == M_WIN) { if (!(64 * j + 63 <= twmin && twmax - 64 * j < 512)) { const int dq = c.t - 64 * j - 4 * c.hi;
#pragma unroll
                        for (int r = 0; r < 16; ++r) { const int cc = (r & 3) + 8 * (r >> 2);
                            if ((unsigned)(dq - cc) >= 512u) p0[r] = NEG; if ((unsigned)(dq - cc - 32) >= 512u) p1[r] = NEG; } } }
                else { const unsigned sb = SELBIT(j);
                    if (j == jd) { const int dq = c.t - 64 * j - 4 * c.hi;
#pragma unroll
                        for (int r = 0; r < 16; ++r) { const int cc = (r & 3) + 8 * (r >> 2);
                            if (dq - cc < 0) p0[r] = NEG; if (dq - cc - 32 < 0) p1[r] = NEG; } }
                    if (!__all(sb != 0u)) { if (!sb) {
#pragma unroll
                            for (int r = 0; r < 16; ++r) { p0[r] = NEG; p1[r] = NEG; } } } }
            }
            if (MODE == M_CMP2) {
#pragma unroll
                for (int r = 0; r < 16; ++r) { p0[r] = __builtin_amdgcn_exp2f(p0[r] - m_reg) * inv_l; p1[r] = __builtin_amdgcn_exp2f(p1[r] - m_reg) * inv_l; }
                float w[8], cy[8];
#pragma unroll
                for (int s = 0; s < 8; ++s) { const int gi = s & 3;
                    const float x0 = (s >> 2) ? p1[4 * gi] : p0[4 * gi], x1 = (s >> 2) ? p1[4 * gi + 1] : p0[4 * gi + 1], x2 = (s >> 2) ? p1[4 * gi + 2] : p0[4 * gi + 2], x3 = (s >> 2) ? p1[4 * gi + 3] : p0[4 * gi + 3];
                    cy[s] = quad_sum(0.5f * x3); w[s] = quad_sum((x0 + x1) + x2) + cy[s]; }
                float pc[8];
#pragma unroll
                for (int s = 0; s < 8; ++s) pc[s] = partner32(cy[s], c.hi);
#pragma unroll
                for (int s = 0; s < 8; ++s) w[s] += c.hi ? pc[s] : (s == 0 ? prev_cy : pc[s - 1]);
                prev_cy = pc[7];
                if ((c.r32 & 3) == 0) {
#pragma unroll
                    for (int s = 0; s < 8; ++s) imp[(c.r32 >> 2) * 128 + j * 16 + 2 * s + c.hi] = w[s]; }
                bf16x8 pa0, pa1, pa2, pa3; pack_p(p0, p1, pa0, pa1, pa2, pa3);
                pv_tile(o, c.vb0 + cur * SHM, pa0, pa1, pa2, pa3);
            } else {
                float mx0 = p0[0], mx1 = p1[0];
#pragma unroll
                for (int r = 1; r < 16; ++r) { mx0 = fmaxf(mx0, p0[r]); mx1 = fmaxf(mx1, p1[r]); }
                const float pmax = half_max(CMP ? fmaxf(mx0, mx1) : fmaxf(mx0, mx1 + s32) + hb);
                const float mn = fmaxf(m_reg, pmax), alpha = __builtin_amdgcn_exp2f(m_reg - mn); m_reg = mn;
                const float off0 = CMP ? -mn : hb - mn, off1 = CMP ? -mn : off0 + s32; float ps = 0.f;
#pragma unroll
                for (int r = 0; r < 16; ++r) { p0[r] = __builtin_amdgcn_exp2f(p0[r] + off0); p1[r] = __builtin_amdgcn_exp2f(p1[r] + off1); ps += p0[r] + p1[r]; }
                ps = half_sum(ps);
                l_reg = l_reg * alpha + ps;
                if (MODE != M_CMP1) {
                    if (__any(alpha < 1.f)) { if (c.hi == 0) ws[32 + c.r32] = alpha; asm volatile("s_waitcnt lgkmcnt(0)" ::: "memory");
#pragma unroll
                        for (int r = 0; r < 16; ++r) { const float a = ws[32 + crow(r, c.hi)];
#pragma unroll
                            for (int d = 0; d < 4; ++d) o[d][r] *= a; } }
                    bf16x8 pa0, pa1, pa2, pa3; pack_p(p0, p1, pa0, pa1, pa2, pa3);
                    pv_tile(o, c.vb0 + cur * SHM, pa0, pa1, pa2, pa3);
                }
            }
        }
        asm volatile("s_waitcnt vmcnt(0)" ::: "memory");
        __syncthreads();
        j0 = j1; h0 = h1; NEXT_T(j1, h1); cur ^= 1;
    }
#undef NEXT_T
#undef SELBIT
}

template <int MODE>
DI void nsa_issue(const NsaCtx& c, int nt_or_jlo, int jhi, const unsigned* uni) {
    constexpr bool NEEDV = (MODE != M_CMP1), CMP = (MODE == M_CMP1 || MODE == M_CMP2);
    const size_t rowbase = (size_t)c.b * T_;
    const bf16_t* Kb; const bf16_t* Vb; const int pitch = CMP ? 128 : LDP0;
    if (CMP) { Kb = c.kcmp + (size_t)(c.b * 4 + c.g) * 512 * 128; Vb = c.vcmp + (size_t)(c.b * 4 + c.g) * 512 * 128; }
    else if (MODE == M_SLC) { Kb = c.proj + rowbase * LDP0 + C_KS + c.g * 128; Vb = c.proj + rowbase * LDP0 + C_VS + c.g * 128; }
    else { Kb = c.proj + rowbase * LDP0 + C_KW + c.g * 128; Vb = c.proj + rowbase * LDP0 + C_VW + c.g * 128; }
    DmaOff D; dma_init(D, c.wid, c.lane, pitch);
    int j0 = 0; bool h0 = false;
    if (MODE == M_SLC) {
#pragma unroll
        for (int w = 3; w >= 0; --w) { if (!h0 && uni[w]) { j0 = 32 * w + 31 - __builtin_clz(uni[w]); h0 = true; } } }
    else if (CMP) { j0 = 0; h0 = 0 < nt_or_jlo; }
    else { j0 = jhi; h0 = jhi >= nt_or_jlo; }
    __syncthreads();
    if (h0) dma_tile<NEEDV>(c.lds, D, Kb + (size_t)j0 * 64 * pitch, Vb + (size_t)j0 * 64 * pitch, 0, c.wid);
}

template <bool ADD> DI void stage_put(const NsaCtx& c, const f32x16* o, float rowscale) {
    LAS float* ws = (LAS float*)(c.lds + L_WS) + c.wid * 128;
    LAS char* st = c.lds + L_STG + c.wid * STG_W;
    if (c.hi == 0) ws[c.r32] = rowscale;
    asm volatile("s_waitcnt lgkmcnt(0)" ::: "memory");
    const bool ev = (c.r32 & 1) == 0;
#pragma unroll
    for (int rg = 0; rg < 4; ++rg) {
        unsigned prev[16]; float s[4];
#pragma unroll
        for (int rr = 0; rr < 4; ++rr) { const int row = crow(rg * 4 + rr, c.hi); s[rr] = ws[row];
#pragma unroll
            for (int d0 = 0; d0 < 4; ++d0) prev[rr * 4 + d0] = (ADD && ev) ? *(const LAS unsigned*)(st + row * 272 + (d0 * 32 + c.r32) * 2) : 0u; }
        asm volatile("s_waitcnt lgkmcnt(0)" ::: "memory");
#pragma unroll
        for (int rr = 0; rr < 4; ++rr) { const int r = rg * 4 + rr, row = crow(r, c.hi);
#pragma unroll
            for (int d0 = 0; d0 < 4; ++d0) { float v = o[d0][r] * s[rr]; float vn = __uint_as_float(DPP_U32(__float_as_uint(v), 0xB1));
                if (ADD) { v += bflo(prev[rr * 4 + d0]); vn += bfhi(prev[rr * 4 + d0]); }
                if (ev) *(LAS unsigned*)(st + row * 272 + (d0 * 32 + c.r32) * 2) = cvtpk(v, vn); } }
    }
    asm volatile("s_waitcnt lgkmcnt(0)" ::: "memory");
}
DI void stage_flush(const NsaCtx& c, bf16_t* att) {
    const LAS char* st = c.lds + L_STG + c.wid * STG_W;
#pragma unroll
    for (int i = 0; i < 8; ++i) { const int ch = i * 64 + c.lane, row = ch >> 4, part = ch & 15;
        const u32x4 v = *(const LAS u32x4*)(st + row * 272 + part * 16);
        *(u32x4*)(att + (size_t)(c.b * T_ + c.t0 + c.wid * 8 + (row >> 2)) * DM + (c.g * 4 + (row & 3)) * 128 + part * 8) = v; }
}
DI void nsa_ctx(NsaCtx& c, LAS char* lds, int item, const bf16_t* proj, const bf16_t* kcmp, const bf16_t* vcmp, const float* gates) {
    c.gates = gates;
    c.lds = lds; c.tid = threadIdx.x; asm volatile("" : "+v"(c.tid));
    c.wid = __builtin_amdgcn_readfirstlane(c.tid >> 6); c.lane = c.tid & 63; c.r32 = c.lane & 31; c.hi = c.lane >> 5;
    c.sr = c.tid >> 4; c.sc = (c.tid & 15) * 8; c.vb0 = (int)(unsigned)(uintptr_t)(lds + L_V) + v_rd_base(c.lane);
    c.b = item >> 9; c.g = (item >> 7) & 3; c.t0 = (item & 127) * 64;
    c.proj = proj; c.kcmp = kcmp; c.vcmp = vcmp;
    const int q8 = c.r32 >> 2, hr = c.r32 & 3, head = c.g * 4 + hr; c.t = c.t0 + c.wid * 8 + q8;
    c.slope2 = __builtin_amdgcn_exp2f(-0.5f * (float)(head + 1)) * LOG2E;
    c.sel0 = c.sel1 = c.sel2 = c.sel3 = 0u;
}
DI void nsa_loadq(const NsaCtx& c, const float* qk_gain, bf16x8* qr, float* gate) {
    const int head = c.g * 4 + (c.r32 & 3);
    const size_t tokrow = (size_t)(c.b * T_ + c.t) * LDP0;
    float qf[64]; float ss = 0.f;
    const bf16_t* qp = c.proj + tokrow + C_Q + head * 128 + c.hi * 8;
#pragma unroll
    for (int d0 = 0; d0 < 8; ++d0) { const u32x4 raw = *(const u32x4*)(qp + d0 * 16);
#pragma unroll
        for (int e = 0; e < 4; ++e) { const float a = bflo(raw[e]), bq = bfhi(raw[e]); qf[d0 * 8 + 2 * e] = a; qf[d0 * 8 + 2 * e + 1] = bq; ss += a * a + bq * bq; } }
    ss = half_sum(ss);
    const float rs = __builtin_amdgcn_rsqf(ss * (1.0f / 128.0f) + 1e-6f) * (QSCALE * LOG2E);
#pragma unroll
    for (int d0 = 0; d0 < 8; ++d0) { const float* gp = qk_gain + d0 * 16 + c.hi * 8; const f32x4 g0 = *(const f32x4*)gp, g1 = *(const f32x4*)(gp + 4);
        f32x4 a = {qf[d0 * 8] * rs * g0[0], qf[d0 * 8 + 1] * rs * g0[1], qf[d0 * 8 + 2] * rs * g0[2], qf[d0 * 8 + 3] * rs * g0[3]};
        f32x4 bq = {qf[d0 * 8 + 4] * rs * g1[0], qf[d0 * 8 + 5] * rs * g1[1], qf[d0 * 8 + 6] * rs * g1[2], qf[d0 * 8 + 7] * rs * g1[3]};
        qr[d0] = pack8(a, bq); }
#pragma unroll
    for (int br = 0; br < 3; ++br) gate[br] = c.gates[(size_t)(c.b * T_ + c.t) * 48 + br * 16 + head];
}
DI void nsa_item(LAS char* lds, int item, const bf16_t* proj, const bf16_t* kcmp, const bf16_t* vcmp, const float* gates, const float* qk_gain, bf16_t* att) {
    NsaCtx c; bf16x8 qr[8]; float gate[3];
    nsa_ctx(c, lds, item, proj, kcmp, vcmp, gates);
    int nkt = ((c.t0 >> 4) + 2) / 64 + 1; if (nkt > 8) nkt = 8;
    nsa_issue<M_CMP1>(c, nkt, 0, nullptr);
    nsa_loadq(c, qk_gain, qr, gate);
    LAS float* imp = (LAS float*)(lds + L_STG + c.wid * STG_W);
#pragma unroll
    for (int i = 0; i < 16; ++i) imp[i * 64 + c.lane] = 0.f;
    LAS unsigned* selm = (LAS unsigned*)(lds + L_SEL);
    LAS unsigned* uni = (LAS unsigned*)(lds + L_UNI);
    if (c.tid < 4) uni[c.tid] = 0u;
    f32x16 o[4] = {};
    float m_c = -1e30f, l_c = 0.f;
    nsa_pass<M_CMP1, true>(c, qr, o, m_c, l_c, 0.f, nkt, 0, nullptr);
    const float inv_l = l_c > 0.f ? __builtin_amdgcn_rcpf(l_c) : 0.f;
    nsa_pass<M_CMP2>(c, qr, o, m_c, l_c, inv_l, nkt, 0, nullptr);
    {
        unsigned k0[8], k1[8];
        const int j0 = c.lane, j1 = c.lane + 64;
#pragma unroll
        for (int q = 0; q < 8; ++q) { const int jd = (c.t0 + c.wid * 8 + q) >> 6;
            const float v0 = imp[q * 128 + c.lane], v1 = imp[q * 128 + 64 + c.lane];
            k0[q] = j0 > jd ? 0u : (((j0 == 0 || j0 == jd) ? 0x80000000u : (((__float_as_uint(v0) >> 7) + 1u) << 7)) | (unsigned)(127 - j0));
            k1[q] = j1 > jd ? 0u : (((j1 == jd) ? 0x80000000u : (((__float_as_uint(v1) >> 7) + 1u) << 7)) | (unsigned)(127 - j1)); }
        asm volatile("s_waitcnt lgkmcnt(0)" ::: "memory");
        stage_put<false>(c, o, gate[0]);
        unsigned T[8];
#pragma unroll
        for (int q = 0; q < 8; ++q) T[q] = 0u;
        for (int bit = 31; bit >= 0; --bit) {
#pragma unroll
            for (int q = 0; q < 8; ++q) { const unsigned cand = T[q] | (1u << bit);
                const int cnt = __builtin_popcountll(__ballot(k0[q] >= cand)) + __builtin_popcountll(__ballot(k1[q] >= cand));
                T[q] = cnt >= 16 ? cand : T[q]; }
        }
#pragma unroll
        for (int q = 0; q < 8; ++q) { const unsigned th = T[q] ? T[q] : 1u;
            const unsigned long long lo = __ballot(k0[q] >= th), hi64 = __ballot(k1[q] >= th);
            if (c.lane == 0) { const int qi = (c.wid * 8 + q) * 4;
                selm[qi] = (unsigned)lo; selm[qi + 1] = (unsigned)(lo >> 32); selm[qi + 2] = (unsigned)hi64; selm[qi + 3] = (unsigned)(hi64 >> 32);
                __hip_atomic_fetch_or(uni + 0, (unsigned)lo, __ATOMIC_RELAXED, __HIP_MEMORY_SCOPE_WORKGROUP); __hip_atomic_fetch_or(uni + 1, (unsigned)(lo >> 32), __ATOMIC_RELAXED, __HIP_MEMORY_SCOPE_WORKGROUP);
                __hip_atomic_fetch_or(uni + 2, (unsigned)hi64, __ATOMIC_RELAXED, __HIP_MEMORY_SCOPE_WORKGROUP); __hip_atomic_fetch_or(uni + 3, (unsigned)(hi64 >> 32), __ATOMIC_RELAXED, __HIP_MEMORY_SCOPE_WORKGROUP); }
        }
    }
    __syncthreads();
    unsigned un[4];
    {
#pragma unroll
        for (int i = 0; i < 4; ++i) un[i] = (unsigned)__builtin_amdgcn_readfirstlane((int)uni[i]);
        const int qi = (c.wid * 8 + (c.r32 >> 2)) * 4; c.sel0 = selm[qi]; c.sel1 = selm[qi + 1]; c.sel2 = selm[qi + 2]; c.sel3 = selm[qi + 3];
    }
#pragma unroll
    for (int d = 0; d < 4; ++d) o[d] = f32x16{};
    float m_s = -1e30f, l_s = 0.f;
    nsa_pass<M_SLC>(c, qr, o, m_s, l_s, 0.f, 0, 0, un);
    stage_put<true>(c, o, gate[1] * (l_s > 0.f ? __builtin_amdgcn_rcpf(l_s) : 0.f));
#pragma unroll
    for (int d = 0; d < 4; ++d) o[d] = f32x16{};
    float m_w = -1e30f, l_w = 0.f;
    const int jhi = c.t0 >> 6, jlo = jhi - 8 > 0 ? jhi - 8 : 0;
    nsa_pass<M_WIN>(c, qr, o, m_w, l_w, 0.f, jlo, jhi, nullptr);
    stage_put<true>(c, o, gate[2] * (l_w > 0.f ? __builtin_amdgcn_rcpf(l_w) : 0.f));
    stage_flush(c, att);
    __syncthreads();
}
}

namespace at {
DI void sb_item(LAS char* lds, int item, const bf16_t* proj, bf16_t* att) {
    constexpr int SB_K = 0, SB_V = 4 * SHM;
    int tid = threadIdx.x; asm volatile("" : "+v"(tid));
    const int wid = __builtin_amdgcn_readfirstlane(tid >> 6), lane = tid & 63, r32 = lane & 31, hi = lane >> 5, half = wid >> 2, wq = wid & 3;
    const int b = item >> 9, hp = (item >> 6) & 7, qb = item & 63, h = hp * 2 + half, q0 = qb * 128, t = q0 + wq * 32 + r32;
    const int vb0 = (int)(unsigned)(uintptr_t)(lds + SB_V + half * 2 * SHM) + v_rd_base(lane);
    LAS unsigned* flg = (LAS unsigned*)(lds + L_FLAG);
    const bf16_t* Kb = proj + (size_t)b * T_ * LDP1 + DM + h * 128; const bf16_t* Vb = proj + (size_t)b * T_ * LDP1 + 2 * DM + h * 128;
    unsigned ko[4], vo[4];
#pragma unroll
    for (int i = 0; i < 4; ++i) { int r_, c_; dma_src_k(i * 4096 + wq * 1024 + lane * 16, r_, c_); ko[i] = (unsigned)(r_ * LDP1 + c_); dma_src_v(i * 4096 + wq * 1024 + lane * 16, r_, c_); vo[i] = (unsigned)(r_ * LDP1 + c_); }
#define SB_DMA(jj, bufi) do { const bf16_t* kt_ = Kb + (size_t)(jj) * 64 * LDP1; const bf16_t* vt_ = Vb + (size_t)(jj) * 64 * LDP1; \
        _Pragma("unroll") for (int i_ = 0; i_ < 4; ++i_) { \
            __builtin_amdgcn_global_load_lds((const unsigned*)(kt_ + ko[i_]), (LAS unsigned*)(lds + SB_K + (half * 2 + (bufi)) * SHM + i_ * 4096 + wq * 1024), 16, 0, 0); \
            __builtin_amdgcn_global_load_lds((const unsigned*)(vt_ + vo[i_]), (LAS unsigned*)(lds + SB_V + (half * 2 + (bufi)) * SHM + i_ * 4096 + wq * 1024), 16, 0, 0); } } while (0)
    int jt = qb * 2 + 1, buf = 0;
    __syncthreads();
    if (tid < 16) flg[tid] = 0u;
    SB_DMA(jt, 0);
    bf16x8 qr[8];
    {
        const bf16_t* qp = proj + (size_t)(b * T_ + t) * LDP1 + h * 128 + hi * 8; const float sc2 = QSCALE * LOG2E;
#pragma unroll
        for (int d0 = 0; d0 < 8; ++d0) { const u32x4 raw = *(const u32x4*)(qp + d0 * 16);
            f32x4 a = {bflo(raw[0]) * sc2, bfhi(raw[0]) * sc2, bflo(raw[1]) * sc2, bfhi(raw[1]) * sc2}, bq = {bflo(raw[2]) * sc2, bfhi(raw[2]) * sc2, bflo(raw[3]) * sc2, bfhi(raw[3]) * sc2};
            qr[d0] = pack8(a, bq); }
    }
    f32x16 o[4] = {}; float carry = 0.f; bool wdone = false;
    const int twmax = q0 + wq * 32 + 31;
    asm volatile("s_waitcnt vmcnt(0)" ::: "memory");
    __syncthreads();
    for (int itn = 0;; ++itn) {
        if (itn > 0) { unsigned nd = 0;
#pragma unroll
            for (int i = 0; i < 8; ++i) nd += flg[((itn - 1) & 1) * 8 + i];
            if (__builtin_amdgcn_readfirstlane((int)nd) == 8) break; }
        const int jn = jt - 1;
        if (jn >= 0) SB_DMA(jn, buf ^ 1);
        if (!wdone && 64 * jt < twmax) {
            f32x16 p0, p1;
            qkt(p0, p1, lds + SB_K + (half * 2 + buf) * SHM, r32, hi, qr);
            const int dq = t - 64 * jt - 4 * hi;
            f32x16 l0, l1;
            const float NEG = -__builtin_inff();
#pragma unroll
            for (int r = 0; r < 16; ++r) { const int cc = (r & 3) + 8 * (r >> 2);
                { const float z = p0[r]; const float sp = fmaxf(z, 0.f) + __builtin_amdgcn_logf(1.0f + __builtin_amdgcn_exp2f(-fabsf(z))); const bool v = (dq - cc) > 0; l0[r] = v ? -sp : 0.f; p0[r] = v ? z - sp : NEG; }
                { const float z = p1[r]; const float sp = fmaxf(z, 0.f) + __builtin_amdgcn_logf(1.0f + __builtin_amdgcn_exp2f(-fabsf(z))); const bool v = (dq - cc - 32) > 0; l1[r] = v ? -sp : 0.f; p1[r] = v ? z - sp : NEG; } }
            float own[8], par[8], aft[8];
#pragma unroll
            for (int gi = 0; gi < 4; ++gi) { own[gi] = (l0[4 * gi] + l0[4 * gi + 1]) + (l0[4 * gi + 2] + l0[4 * gi + 3]); own[4 + gi] = (l1[4 * gi] + l1[4 * gi + 1]) + (l1[4 * gi + 2] + l1[4 * gi + 3]); }
#pragma unroll
            for (int pi = 0; pi < 8; ++pi) par[pi] = partner32(own[pi], hi);
            float run = 0.f;
#pragma unroll
            for (int pi = 7; pi >= 0; --pi) { aft[pi] = run + (hi == 0 ? par[pi] : 0.f); run += own[pi] + par[pi]; }
#pragma unroll
            for (int gi = 0; gi < 4; ++gi) {
                { float a = carry + aft[gi]; p0[4 * gi + 3] = __builtin_amdgcn_exp2f(p0[4 * gi + 3] + a); a += l0[4 * gi + 3]; p0[4 * gi + 2] = __builtin_amdgcn_exp2f(p0[4 * gi + 2] + a); a += l0[4 * gi + 2];
                  p0[4 * gi + 1] = __builtin_amdgcn_exp2f(p0[4 * gi + 1] + a); a += l0[4 * gi + 1]; p0[4 * gi] = __builtin_amdgcn_exp2f(p0[4 * gi] + a); }
                { float a = carry + aft[4 + gi]; p1[4 * gi + 3] = __builtin_amdgcn_exp2f(p1[4 * gi + 3] + a); a += l1[4 * gi + 3]; p1[4 * gi + 2] = __builtin_amdgcn_exp2f(p1[4 * gi + 2] + a); a += l1[4 * gi + 2];
                  p1[4 * gi + 1] = __builtin_amdgcn_exp2f(p1[4 * gi + 1] + a); a += l1[4 * gi + 1]; p1[4 * gi] = __builtin_amdgcn_exp2f(p1[4 * gi] + a); } }
            carry += run;
            bf16x8 pa0, pa1, pa2, pa3; pack_p(p0, p1, pa0, pa1, pa2, pa3);
            pv_tile(o, vb0 + buf * SHM, pa0, pa1, pa2, pa3);
            if (__all(carry < -160.f)) wdone = true;
        }
        if (wdone && lane == 0) flg[(itn & 1) * 8 + wid] = 1u;
        asm volatile("s_waitcnt vmcnt(0)" ::: "memory");
        __syncthreads();
        if (jn < 0) break;
        jt = jn; buf ^= 1;
    }
#undef SB_DMA
    {
        LAS char* st = lds + wid * STG_W;
#pragma unroll
        for (int r = 0; r < 16; ++r) { const int row = crow(r, hi);
#pragma unroll
            for (int d0 = 0; d0 < 4; ++d0) { const float v = o[d0][r]; const float vn = __shfl_xor(v, 1);
                if ((r32 & 1) == 0) *(LAS unsigned*)(st + row * 272 + (d0 * 32 + r32) * 2) = cvtpk(v, vn); } }
        asm volatile("s_waitcnt lgkmcnt(0)" ::: "memory");
#pragma unroll
        for (int i = 0; i < 8; ++i) { const int ch = i * 64 + lane, row = ch >> 4, part = ch & 15;
            const u32x4 v = *(const LAS u32x4*)(st + row * 272 + part * 16);
            *(u32x4*)(att + (size_t)(b * T_ + q0 + wq * 32 + row) * DM + h * 128 + part * 8) = v; }
    }
}
}

struct TcJob { const float* src; bf16_t* dst; int ld, nvalid, K, k0, n0; };
DI void tconv_load(const TcJob& J, f32x4 (&v)[8]) {
    const int tid = threadIdx.x;
#pragma unroll
    for (int i = 0; i < 8; ++i) { const int idx = tid + 512 * i, k = idx >> 5, n4 = idx & 31;
        v[i] = (f32x4){0.f, 0.f, 0.f, 0.f};
        if (J.n0 + 4 * n4 < J.nvalid) v[i] = __builtin_nontemporal_load((const f32x4*)(J.src + (size_t)(J.k0 + k) * J.ld + J.n0 + 4 * n4)); }
}
DI void tconv_lds(const f32x4 (&v)[8], LAS unsigned char* lds) {
    const int tid = threadIdx.x; constexpr int RS = 264;
#pragma unroll
    for (int i = 0; i < 8; ++i) { const int idx = tid + 512 * i, k = idx >> 5, n4 = idx & 31;
        u32x2 w = {cvtpk(v[i][0], v[i][1]), cvtpk(v[i][2], v[i][3])};
        *(LAS u32x2*)(lds + k * RS + n4 * 8) = w; }
}
DI void tconv_tr(LAS unsigned char* lds, LAS unsigned char* img2) {
    const int tid = threadIdx.x, lane = tid & 63; constexpr int RS = 264;
    const int n = tid & 127, kq = tid >> 7;
    const unsigned ad = (unsigned)(uintptr_t)lds + (unsigned)((kq * 32 + ((lane >> 2) & 3)) * RS + (n & ~15) * 2 + 8 * (lane & 3));
    s16x4 lo[4], hi[4];
#define TCRD(dst, off) asm volatile("ds_read_b64_tr_b16 %0, %1 offset:%2" : "=&v"(dst) : "v"(ad), "i"(off) : "memory")
    TCRD(lo[0], 0 * RS); TCRD(hi[0], 4 * RS); TCRD(lo[1], 8 * RS); TCRD(hi[1], 12 * RS); TCRD(lo[2], 16 * RS); TCRD(hi[2], 20 * RS); TCRD(lo[3], 24 * RS); TCRD(hi[3], 28 * RS);
#undef TCRD
    asm volatile("s_waitcnt lgkmcnt(0)" ::: "memory");
#pragma unroll
    for (int j = 0; j < 4; ++j) { const bf16x8 w = __builtin_shufflevector(lo[j], hi[j], 0, 1, 2, 3, 4, 5, 6, 7);
        *(LAS bf16x8*)(img2 + n * 272 + (kq * 32 + j * 8) * 2) = w; }
}
DI void tconv_store(const TcJob& J, const LAS unsigned char* img2) {
    const int tid = threadIdx.x;
#pragma unroll
    for (int i = 0; i < 4; ++i) { const int p = tid + 512 * i, n = p >> 4, k8 = p & 15;
        const bf16x8 w = *(const LAS bf16x8*)(img2 + n * 272 + k8 * 16);
        *(bf16x8*)(J.dst + (size_t)n * J.K + J.k0 + k8 * 8) = w; }
}
DI void norm_row(const float* xrow, const float* g, bf16_t* hrow, int lane) {
    f32x4 v[8]; float ss = 0.f;
#pragma unroll
    for (int i = 0; i < 8; ++i) { v[i] = *(const f32x4*)(xrow + i * 256 + lane * 4); ss += (v[i][0] * v[i][0] + v[i][1] * v[i][1]) + (v[i][2] * v[i][2] + v[i][3] * v[i][3]); }
    ss = wave_sum(ss);
    const float rs = __builtin_amdgcn_rsqf(ss * (1.0f / 2048.0f) + 1e-6f);
#pragma unroll
    for (int i = 0; i < 8; ++i) { const f32x4 gg = *(const f32x4*)(g + i * 256 + lane * 4);
        u32x2 w = {cvtpk(v[i][0] * rs * gg[0], v[i][1] * rs * gg[1]), cvtpk(v[i][2] * rs * gg[2], v[i][3] * rs * gg[3])};
        *(u32x2*)(hrow + i * 256 + lane * 4) = w; }
}

template <bool B16> DI void norm_rows4(const void* xv, const bf16_t* z, const float* g, bf16_t* h, int row0, int lane) {
    f32x4 v[4][8]; float ss[4];
#pragma unroll
    for (int r = 0; r < 4; ++r)
#pragma unroll
        for (int i = 0; i < 8; ++i) {
            if (B16) { const u32x2 xx = *(const u32x2*)((const bf16_t*)xv + (size_t)(row0 + r) * DM + i * 256 + lane * 4); v[r][i] = (f32x4){bflo(xx[0]), bfhi(xx[0]), bflo(xx[1]), bfhi(xx[1])}; }
            else v[r][i] = *(const f32x4*)((const float*)xv + (size_t)(row0 + r) * DM + i * 256 + lane * 4); }
    if (z) {
#pragma unroll
        for (int r = 0; r < 4; ++r)
#pragma unroll
            for (int i = 0; i < 8; ++i) { const u32x2 zz = *(const u32x2*)(z + (size_t)(row0 + r) * DM + i * 256 + lane * 4);
                v[r][i][0] += bflo(zz[0]); v[r][i][1] += bfhi(zz[0]); v[r][i][2] += bflo(zz[1]); v[r][i][3] += bfhi(zz[1]); } }
#pragma unroll
    for (int r = 0; r < 4; ++r) { float s = 0.f;
#pragma unroll
        for (int i = 0; i < 8; ++i) s += (v[r][i][0] * v[r][i][0] + v[r][i][1] * v[r][i][1]) + (v[r][i][2] * v[r][i][2] + v[r][i][3] * v[r][i][3]);
        ss[r] = s; }
#pragma unroll
    for (int o = 32; o >= 1; o >>= 1) {
#pragma unroll
        for (int r = 0; r < 4; ++r) ss[r] += __shfl_xor(ss[r], o); }
#pragma unroll
    for (int i = 0; i < 8; ++i) { const f32x4 gg = *(const f32x4*)(g + i * 256 + lane * 4);
#pragma unroll
        for (int r = 0; r < 4; ++r) { const float rs = __builtin_amdgcn_rsqf(ss[r] * (1.0f / 2048.0f) + 1e-6f);
            u32x2 w = {cvtpk(v[r][i][0] * rs * gg[0], v[r][i][1] * rs * gg[1]), cvtpk(v[r][i][2] * rs * gg[2], v[r][i][3] * rs * gg[3])};
            *(u32x2*)(h + (size_t)(row0 + r) * DM + i * 256 + lane * 4) = w; } }
}

struct Args { const float* in[18]; float* out; unsigned char* ws; int ph_lo, ph_hi; };

template <int SET> DI void conv_jobs(const Args& a, LAS unsigned char* lds, int q0 = -1, int qstep = 0, int qlim = -1) {
    const int G = qstep > 0 ? qstep : (int)gridDim.x, bx = q0 >= 0 ? q0 : (int)blockIdx.x;
    typedef __attribute__((address_space(4))) const unsigned long long KArg;
#define KIN(k) ((const float*)((KArg*)__builtin_amdgcn_kernarg_segment_ptr())[k])
    unsigned char* ws = (unsigned char*)((KArg*)__builtin_amdgcn_kernarg_segment_ptr())[19];
    constexpr int J0 = 672, J1 = J0 + 256, J2 = J1 + 768, J3 = J2 + 256, J4 = J3 + 4096, J5 = J4 + 4096, J6 = J5 + 4096, J7 = J6 + 64, J8 = J7 + 2;
#define TC_DECODE(J, job) do { int kt_; \
        if (job < J0) { const int i = job; kt_ = i % 16; J.n0 = (i / 16) * 128; J.src = KIN(3); J.ld = 5168; J.nvalid = 5168; J.K = 2048; J.dst = (bf16_t*)(ws + WS_WIN0) + (size_t)J.n0 * 2048; } \
        else if (job < J1) { const int i = job - J0; kt_ = i % 16; J.n0 = (i / 16) * 128; J.src = KIN(8); J.ld = 2048; J.nvalid = 2048; J.K = 2048; J.dst = (bf16_t*)(ws + WS_WOUT0) + (size_t)J.n0 * 2048; } \
        else if (job < J2) { const int i = job - J1; kt_ = i % 16; J.n0 = (i / 16) * 128; J.src = KIN(9); J.ld = 6144; J.nvalid = 6144; J.K = 2048; J.dst = (bf16_t*)(ws + WS_WIN1) + (size_t)J.n0 * 2048; } \
        else if (job < J3) { const int i = job - J2; kt_ = i % 16; J.n0 = (i / 16) * 128; J.src = KIN(10); J.ld = 2048; J.nvalid = 2048; J.K = 2048; J.dst = (bf16_t*)(ws + WS_WOUT1) + (size_t)J.n0 * 2048; } \
        else if (job < J5) { const bool up = job >= J4; const int i = job - (up ? J4 : J3); const int mat = i >> 6, r = i & 63; kt_ = r % 16; J.n0 = (r / 16) * 128; \
            J.src = (up ? KIN(16) : KIN(15)) + (size_t)mat * 2048 * 512; J.ld = 512; J.nvalid = 512; J.K = 2048; \
            J.dst = (bf16_t*)(ws + WS_W1) + ((size_t)mat * 1024 + (J.n0 / 128) * 256 + (up ? 128 : 0)) * 2048; } \
        else if (job < J6) { const int i = job - J5; const int mat = i >> 6, r = i & 63; kt_ = r % 4; J.n0 = (r / 4) * 128; \
            J.src = KIN(17) + (size_t)mat * 512 * 2048; J.ld = 2048; J.nvalid = 2048; J.K = 512; J.dst = (bf16_t*)(ws + WS_W2) + ((size_t)mat * 2048 + J.n0) * 512; } \
        else if (job < J7) { const int i = job - J6; const int kv = i >> 5; kt_ = i & 31; J.n0 = 0; J.src = KIN(6) + (size_t)kv * 4096 * 128; J.ld = 128; J.nvalid = 128; J.K = 4096; J.dst = (bf16_t*)(ws + WS_CW1) + (size_t)kv * 128 * 4096; } \
        else { const int kv = job - J7; kt_ = 0; J.n0 = 0; J.src = KIN(7) + (size_t)kv * 128 * 128; J.ld = 128; J.nvalid = 128; J.K = 128; J.dst = (bf16_t*)(ws + WS_CW2) + (size_t)kv * 128 * 128; } \
        J.k0 = kt_ * 128; } while (0)
    constexpr int NQ_ALL = SET == 0 ? 928 + 66 : SET == 1 ? 1024 + 3 * 2048 : 3 * 2048;
    const int NQ = (qlim >= 0 && qlim < NQ_ALL) ? qlim : NQ_ALL;
#define TC_MAP(q) (SET == 0 ? ((q) < 928 ? (q) : 14240 + ((q) - 928)) : SET == 1 ? ((q) < 1024 ? 928 + (q) : (((q) - 1024) >> 11) * 4096 + 1952 + (((q) - 1024) & 2047)) : ((q) >> 11) * 4096 + 4000 + ((q) & 2047))
    {
        int q = bx; f32x4 va[8], vb[8];
        LAS unsigned char* img2 = lds + 128 * 264;
        __syncthreads();
        if (q < NQ) { TcJob J; const int job = TC_MAP(q); TC_DECODE(J, job); tconv_load(J, va); }
        if (q + G < NQ) { TcJob J; const int job = TC_MAP(q + G); TC_DECODE(J, job); tconv_load(J, vb); }
        while (q < NQ) {
            tconv_lds(va, lds);
            __syncthreads();
            if (q + 2 * G < NQ) { TcJob J; const int job = TC_MAP(q + 2 * G); TC_DECODE(J, job); tconv_load(J, va); }
            tconv_tr(lds, img2);
            __syncthreads();
            { TcJob J; const int job = TC_MAP(q); TC_DECODE(J, job); tconv_store(J, img2); }
            q += G; if (q >= NQ) break;
            tconv_lds(vb, lds);
            __syncthreads();
            if (q + 2 * G < NQ) { TcJob J; const int job = TC_MAP(q + 2 * G); TC_DECODE(J, job); tconv_load(J, vb); }
            tconv_tr(lds, img2);
            __syncthreads();
            { TcJob J; const int job = TC_MAP(q); TC_DECODE(J, job); tconv_store(J, img2); }
            q += G;
        }
        __syncthreads();
    }
#undef TC_DECODE
#undef TC_MAP
#undef KIN
}
DI void phase_prologue(const Args& a, LAS unsigned char* lds) {
    const int tid = threadIdx.x, wid = tid >> 6, lane = tid & 63, G = gridDim.x, bx = blockIdx.x;
    unsigned char* ws = a.ws;
    conv_jobs<0>(a, lds);
    for (int i = bx * 512 + tid; i < 2 * 48 * 2048; i += G * 512) { const int k = i & 2047, r = (i >> 11) % 48, L = (i >> 11) / 48;
        float v = 0.f; if (r < 4) v = a.in[11][((size_t)L * 2048 + k) * 4 + r]; else if (r < 36) v = a.in[13][((size_t)L * 2048 + k) * 32 + (r - 4)];
        ((bf16_t*)(ws + WS_WR))[i] = (bf16_t)(cvtpk(v, 0.f) & 0xffffu); }
    for (int o = bx; o < 256; o += G) if (wid == 0) { const int kv = o >> 7, f = o & 127; float s0 = 0.f, s1 = 0.f, s2 = 0.f, s3 = 0.f;
#pragma unroll 4
        for (int kk = lane; kk < 4096; kk += 256) { const float* pe = a.in[5] + kv * 4096 + kk; const float* w1 = a.in[6] + ((size_t)kv * 4096 + kk) * 128 + f;
            s0 += pe[0] * w1[0]; s1 += pe[64] * w1[64 * 128]; s2 += pe[128] * w1[128 * 128]; s3 += pe[192] * w1[192 * 128]; }
        const float s = wave_sum((s0 + s1) + (s2 + s3)); if (lane == 0) ((float*)(ws + WS_BIAS1))[o] = s; }
    for (int row0 = (bx * 8 + wid) * 4; row0 < NTOK; row0 += G * 32) norm_rows4<false>(a.in[0], nullptr, a.in[1], (bf16_t*)(ws + WS_H), row0, lane);
}

DI void phase_norm(const float* x, const float* g, bf16_t* h) {
    const int tid = threadIdx.x, wid = tid >> 6, lane = tid & 63;
    for (int row = blockIdx.x * 8 + wid; row < NTOK; row += gridDim.x * 8) norm_row(x + (size_t)row * DM, g, h + (size_t)row * DM, lane);
}

DI void cmp_item(LAS unsigned char* lds, int item, const bf16_t* proj, const bf16_t* cw1t, const bf16_t* cw2t, const float* bias1, const float* gain1, bf16_t* kcmp, bf16_t* vcmp) {
    const int tid = threadIdx.x, wid = __builtin_amdgcn_readfirstlane(tid >> 6), lane = tid & 63, fr = lane & 15, fq = lane >> 4, kq = wid & 3, nh = wid >> 2;
    const int kv = item >> 7, rt = item & 127, bg = rt >> 4, n0 = (rt & 15) * 32, b = bg >> 2, g = bg & 3;
    int na = n0 + fr, nb = n0 + 16 + fr; na = na < 510 ? na : 510; nb = nb < 510 ? nb : 510;
    const bf16_t* a0p = proj + ((size_t)b * T_ + 16 * na) * LDP0 + C_KC + kv * 512 + g * 128 + fq * 8;
    const bf16_t* a1p = proj + ((size_t)b * T_ + 16 * nb) * LDP0 + C_KC + kv * 512 + g * 128 + fq * 8;
    const bf16_t* bp = cw1t + (size_t)(kv * 128 + nh * 64 + fr) * 4096 + fq * 8;
    f32x4 acc[2][4];
#pragma unroll
    for (int rb = 0; rb < 2; ++rb)
#pragma unroll
        for (int ct = 0; ct < 4; ++ct) acc[rb][ct] = (f32x4){0.f, 0.f, 0.f, 0.f};
#pragma unroll 4
    for (int k2 = 0; k2 < 32; ++k2) { const int ks = kq * 32 + k2, l = ks >> 2, dp = (ks & 3) * 32;
        const bf16x8 a0 = *(const bf16x8*)(a0p + (size_t)l * LDP0 + dp), a1 = *(const bf16x8*)(a1p + (size_t)l * LDP0 + dp);
#pragma unroll
        for (int ct = 0; ct < 4; ++ct) { const bf16x8 bb = *(const bf16x8*)(bp + (size_t)ct * 16 * 4096 + ks * 32);
            acc[0][ct] = __builtin_amdgcn_mfma_f32_16x16x32_bf16(a0, bb, acc[0][ct], 0, 0, 0);
            acc[1][ct] = __builtin_amdgcn_mfma_f32_16x16x32_bf16(a1, bb, acc[1][ct], 0, 0, 0); } }
    constexpr int HP = 272;
    LAS float* red = (LAS float*)(lds + 16384);
    __syncthreads();
#pragma unroll
    for (int rb = 0; rb < 2; ++rb)
#pragma unroll
        for (int ct = 0; ct < 4; ++ct)
#pragma unroll
            for (int j = 0; j < 4; ++j) red[(kq * 32 + rb * 16 + fq * 4 + j) * 128 + nh * 64 + ct * 16 + fr] = acc[rb][ct][j];
    __syncthreads();
#pragma unroll
    for (int i = 0; i < 8; ++i) { const int idx = tid + 512 * i, row = idx >> 7, col = idx & 127;
        const float x = ((red[idx] + red[4096 + idx]) + (red[8192 + idx] + red[12288 + idx])) + bias1[kv * 128 + col];
        const float u = 0.7978845608028654f * (x + 0.044715f * x * x * x);
        const float hv = x * __builtin_amdgcn_rcpf(1.0f + __builtin_amdgcn_exp2f(-2.0f * LOG2E * u));
        *(LAS unsigned short*)(lds + row * HP + col * 2) = (unsigned short)(cvtpk(hv, 0.f) & 0xffffu); }
    __syncthreads();
    f32x4 ac2[2] = {{0.f, 0.f, 0.f, 0.f}, {0.f, 0.f, 0.f, 0.f}};
    const bf16_t* b2base = cw2t + (size_t)(kv * 128 + wid * 16 + fr) * 128 + fq * 8;
#pragma unroll
    for (int ks = 0; ks < 4; ++ks) { const bf16x8 bb = *(const bf16x8*)(b2base + ks * 32);
#pragma unroll
        for (int rb = 0; rb < 2; ++rb) { const bf16x8 aa = *(const LAS bf16x8*)(lds + (rb * 16 + fr) * HP + (ks * 32 + fq * 8) * 2);
            ac2[rb] = __builtin_amdgcn_mfma_f32_16x16x32_bf16(aa, bb, ac2[rb], 0, 0, 0); } }
    LAS float* part = (LAS float*)(lds + 32 * HP);
    float scl[2][4];
    if (kv == 0) {
#pragma unroll
        for (int rb = 0; rb < 2; ++rb)
#pragma unroll
            for (int j = 0; j < 4; ++j) { float s = ac2[rb][j] * ac2[rb][j]; s += __shfl_xor(s, 1); s += __shfl_xor(s, 2); s += __shfl_xor(s, 4); s += __shfl_xor(s, 8);
                if (fr == 0) part[wid * 32 + rb * 16 + fq * 4 + j] = s; }
        __syncthreads();
        const float gn = gain1[wid * 16 + fr];
#pragma unroll
        for (int rb = 0; rb < 2; ++rb)
#pragma unroll
            for (int j = 0; j < 4; ++j) { float s = 0.f;
#pragma unroll
                for (int w = 0; w < 8; ++w) s += part[w * 32 + rb * 16 + fq * 4 + j];
                scl[rb][j] = __builtin_amdgcn_rsqf(s * (1.0f / 128.0f) + 1e-6f) * gn; }
    } else {
#pragma unroll
        for (int rb = 0; rb < 2; ++rb)
#pragma unroll
            for (int j = 0; j < 4; ++j) scl[rb][j] = 1.0f;
    }
    bf16_t* dst = (kv == 0 ? kcmp : vcmp) + (size_t)(bg * 512 + n0) * 128 + wid * 16 + fr;
#pragma unroll
    for (int rb = 0; rb < 2; ++rb)
#pragma unroll
        for (int j = 0; j < 4; ++j) dst[(size_t)(rb * 16 + fq * 4 + j) * 128] = (bf16_t)(cvtpk(ac2[rb][j] * scl[rb][j], 0.f) & 0xffffu);
    __syncthreads();
}
DI void knorm_phase(bf16_t* proj, const float* qk_gain) {
    const int gid = blockIdx.x * 512 + threadIdx.x, sub = gid & 15, stride = gridDim.x * 32;
    for (int rowid0 = gid >> 4; rowid0 < NTOK * 8; rowid0 += 4 * stride) {
        u32x4 raw[4]; bf16_t* p[4]; int sw[4];
#pragma unroll
        for (int u = 0; u < 4; ++u) { int rowid = rowid0 + u * stride; rowid = rowid < NTOK * 8 ? rowid : NTOK * 8 - 1; const int tok = rowid >> 3, selw = (rowid >> 2) & 1, g = rowid & 3; sw[u] = selw;
            p[u] = proj + (size_t)tok * LDP0 + (selw ? C_KW : C_KS) + g * 128 + sub * 8; raw[u] = *(const u32x4*)p[u]; }
#pragma unroll
        for (int u = 0; u < 4; ++u) { float f[8]; float ss = 0.f;
#pragma unroll
            for (int e = 0; e < 4; ++e) { f[2 * e] = bflo(raw[u][e]); f[2 * e + 1] = bfhi(raw[u][e]); ss += f[2 * e] * f[2 * e] + f[2 * e + 1] * f[2 * e + 1]; }
            ss += __shfl_xor(ss, 1); ss += __shfl_xor(ss, 2); ss += __shfl_xor(ss, 4); ss += __shfl_xor(ss, 8);
            const float rs = __builtin_amdgcn_rsqf(ss * (1.0f / 128.0f) + 1e-6f);
            const float* gp = qk_gain + (sw[u] ? 3 : 2) * 128 + sub * 8; const f32x4 g0 = *(const f32x4*)gp, g1 = *(const f32x4*)(gp + 4);
            u32x4 w = {cvtpk(f[0] * rs * g0[0], f[1] * rs * g0[1]), cvtpk(f[2] * rs * g0[2], f[3] * rs * g0[3]), cvtpk(f[4] * rs * g1[0], f[5] * rs * g1[1]), cvtpk(f[6] * rs * g1[2], f[7] * rs * g1[3])};
            if (rowid0 + u * stride < NTOK * 8) *(u32x4*)p[u] = w; }
    }
}
DI void mini_gemm48(LAS unsigned char* lds, const bf16_t* A, const bf16_t* Wt) {
    const int tid = threadIdx.x, wid = __builtin_amdgcn_readfirstlane(tid >> 6), lane = tid & 63, fr = lane & 15, fq = lane >> 4, rb = wid & 3, kh = wid >> 2;
    const bf16_t* ap = A + (size_t)(rb * 16 + fr) * DM + kh * 1024 + fq * 8;
    const bf16_t* bp = Wt + (size_t)fr * DM + kh * 1024 + fq * 8;
    f32x4 acc[3] = {{0.f, 0.f, 0.f, 0.f}, {0.f, 0.f, 0.f, 0.f}, {0.f, 0.f, 0.f, 0.f}};
#pragma unroll 8
    for (int ks = 0; ks < 32; ++ks) { const bf16x8 a = *(const bf16x8*)(ap + ks * 32);
#pragma unroll
        for (int ct = 0; ct < 3; ++ct) { const bf16x8 bb = *(const bf16x8*)(bp + (size_t)ct * 16 * DM + ks * 32); acc[ct] = __builtin_amdgcn_mfma_f32_16x16x32_bf16(a, bb, acc[ct], 0, 0, 0); } }
    LAS float* part = (LAS float*)lds;
    __syncthreads();
#pragma unroll
    for (int ct = 0; ct < 3; ++ct)
#pragma unroll
        for (int j = 0; j < 4; ++j) part[(kh * 64 + rb * 16 + fq * 4 + j) * 48 + ct * 16 + fr] = acc[ct][j];
    __syncthreads();
    LAS float* out = (LAS float*)(lds + 24576);
    for (int i = tid; i < 64 * 48; i += 512) out[i] = part[i] + part[64 * 48 + i];
    __syncthreads();
}
DI void gates_phase(LAS unsigned char* lds, const bf16_t* H, const bf16_t* Wt, float* gates) {
    const int tid = threadIdx.x;
    for (int chunk = blockIdx.x; chunk < NTOK / 64; chunk += gridDim.x) {
        mini_gemm48(lds, H + (size_t)chunk * 64 * DM, Wt);
        const LAS float* out = (const LAS float*)(lds + 24576);
        for (int i = tid; i < 64 * 48; i += 512) gates[(size_t)chunk * 64 * 48 + i] = __builtin_amdgcn_rcpf(1.0f + __builtin_amdgcn_exp2f(-out[i] * LOG2E));
    }
}
template <bool B16> DI void norm_route_phase(LAS unsigned char* lds, const void* x, const bf16_t* z, const float* g, bf16_t* H, const bf16_t* Wt, const float* bgp, const float* brp, unsigned* cnt, int* rows, float* tokinfo) {
    const int tid = threadIdx.x, wid = tid >> 6, lane = tid & 63;
    LAS unsigned* hist = (LAS unsigned*)(lds + 40960); LAS unsigned* base = hist + 32;
    for (int chunk = blockIdx.x; chunk < NTOK / 64; chunk += gridDim.x) {
        norm_rows4<B16>(x, z, g, H, chunk * 64 + wid * 8, lane); norm_rows4<B16>(x, z, g, H, chunk * 64 + wid * 8 + 4, lane);
        if (tid < 32) hist[tid] = 0u;
        asm volatile("s_waitcnt vmcnt(0)" ::: "memory");
        __syncthreads();
        __builtin_amdgcn_fence(__ATOMIC_ACQUIRE, "agent");
        mini_gemm48(lds, H + (size_t)chunk * 64 * DM, Wt);
        const LAS float* out = (const LAS float*)(lds + 24576);
        int e1 = 0, e2 = 0; float w1 = 0.f, w2 = 0.f; unsigned p1 = 0, p2 = 0; const int tok = chunk * 64 + tid;
        if (tid < 64) {
            const LAS float* lg = out + tid * 48;
            float gl[4]; float gm = -3.0e38f; int gs = 0;
#pragma unroll
            for (int i = 0; i < 4; ++i) { gl[i] = lg[i] + bgp[i]; if (gl[i] > gm) { gm = gl[i]; gs = i; } }
            float gsum = 0.f;
#pragma unroll
            for (int i = 0; i < 4; ++i) gsum += __expf(gl[i] - gm);
            const float pg = 1.0f / gsum;
            float el[8]; float m1 = -3.0e38f; int s1 = 0;
#pragma unroll
            for (int i = 0; i < 8; ++i) { el[i] = lg[4 + gs * 8 + i] + brp[gs * 8 + i]; if (el[i] > m1) { m1 = el[i]; s1 = i; } }
            float m2 = -3.0e38f; int s2 = 0;
#pragma unroll
            for (int i = 0; i < 8; ++i) if (i != s1 && el[i] > m2) { m2 = el[i]; s2 = i; }
            const float x2 = __expf(m2 - m1), den = 1.0f / (1.0f + x2);
            w1 = pg * den; w2 = pg * x2 * den; e1 = gs * 8 + s1; e2 = gs * 8 + s2;
            p1 = __hip_atomic_fetch_add(hist + e1, 1u, __ATOMIC_RELAXED, __HIP_MEMORY_SCOPE_WORKGROUP);
            p2 = __hip_atomic_fetch_add(hist + e2, 1u, __ATOMIC_RELAXED, __HIP_MEMORY_SCOPE_WORKGROUP);
        }
        __syncthreads();
        if (tid < 32) { const unsigned hcount = hist[tid]; base[tid] = hcount ? __hip_atomic_fetch_add(cnt + tid, hcount, __ATOMIC_RELAXED, __HIP_MEMORY_SCOPE_AGENT) : 0u; }
        __syncthreads();
        if (tid < 64) { p1 += base[e1]; p2 += base[e2];
            rows[e1 * 16384 + (int)p1] = tok; rows[e2 * 16384 + (int)p2] = tok;
            float* ti = tokinfo + (size_t)tok * 8; ti[0] = __int_as_float(e1); ti[1] = __int_as_float((int)p1); ti[2] = w1; ti[3] = __int_as_float(e2); ti[4] = __int_as_float((int)p2); ti[5] = w2; }
        __syncthreads();
    }
}
DI int moe_tables(LAS unsigned char* misc, const unsigned* cnt) {
    const int tid = threadIdx.x; LAS int* w = (LAS int*)misc;
    __syncthreads();
    if (tid < 32) w[16 + tid] = (int)cnt[tid];
    __syncthreads();
    if (tid == 0) { int acc = 0; for (int e = 0; e < 32; ++e) { w[48 + e] = acc; acc += (w[16 + e] + 255) >> 8; } w[80] = acc; }
    __syncthreads();
    const int ntot = w[80];
    for (int rt = tid; rt < ntot; rt += 512) { int e = 0;
        for (int k = 0; k < 32; ++k) if (w[48 + k] <= rt && rt < w[48 + k + 1]) e = k;
        const int loc = (rt - w[48 + e]) * 256; int nv = w[16 + e] - loc; nv = nv > 256 ? 256 : nv;
        w[128 + rt * 4] = e; w[128 + rt * 4 + 1] = e * 16384 + loc; w[128 + rt * 4 + 2] = nv; w[128 + rt * 4 + 3] = 0; }
    __syncthreads();
    return ntot;
}
template <bool B16> DI void combine_phase(LAS unsigned char* misc, const float* tokinfo, const bf16_t* Y, const void* xbase, const bf16_t* z, bf16_t* xr, float* out, const float* gnext, bf16_t* h) {
    const int tid = threadIdx.x, wid = tid >> 6, lane = tid & 63; const LAS int* w = (const LAS int*)misc;
    for (int tok = blockIdx.x * 8 + wid; tok < NTOK; tok += gridDim.x * 8) {
        const float* ti = tokinfo + (size_t)tok * 8;
        const int e1 = __float_as_int(ti[0]), p1 = __float_as_int(ti[1]), e2 = __float_as_int(ti[3]), p2 = __float_as_int(ti[4]); const float w1 = ti[2], w2 = ti[5];
        const bf16_t* y1 = Y + ((size_t)w[48 + e1] * 256 + p1) * DM; const bf16_t* y2 = Y + ((size_t)w[48 + e2] * 256 + p2) * DM;
        const bf16_t* zp = z + (size_t)tok * DM; bf16_t* xp = xr + (size_t)tok * DM; f32x4 v[8]; float ss = 0.f;
#pragma unroll
        for (int i = 0; i < 8; ++i) { const int col = i * 256 + lane * 4; f32x4 x; if (B16) { const u32x2 xx = *(const u32x2*)((const bf16_t*)xbase + (size_t)tok * DM + col); x = (f32x4){bflo(xx[0]), bfhi(xx[0]), bflo(xx[1]), bfhi(xx[1])}; } else x = *(const f32x4*)((const float*)xbase + (size_t)tok * DM + col);
            const u32x2 zz = *(const u32x2*)(zp + col); x[0] += bflo(zz[0]); x[1] += bfhi(zz[0]); x[2] += bflo(zz[1]); x[3] += bfhi(zz[1]);
            const u32x2 a = *(const u32x2*)(y1 + col), bq = *(const u32x2*)(y2 + col);
            v[i][0] = x[0] + (w1 * bflo(a[0]) + w2 * bflo(bq[0])); v[i][1] = x[1] + (w1 * bfhi(a[0]) + w2 * bfhi(bq[0]));
            v[i][2] = x[2] + (w1 * bflo(a[1]) + w2 * bflo(bq[1])); v[i][3] = x[3] + (w1 * bfhi(a[1]) + w2 * bfhi(bq[1]));
            ss += (v[i][0] * v[i][0] + v[i][1] * v[i][1]) + (v[i][2] * v[i][2] + v[i][3] * v[i][3]); }
        if (out) {
#pragma unroll
            for (int i = 0; i < 8; ++i) *(f32x4*)(out + (size_t)tok * DM + i * 256 + lane * 4) = v[i];
        } else {
            ss = wave_sum(ss); const float rs = __builtin_amdgcn_rsqf(ss * (1.0f / 2048.0f) + 1e-6f);
#pragma unroll
            for (int i = 0; i < 8; ++i) { const int col = i * 256 + lane * 4; { u32x2 xw = {cvtpk(v[i][0], v[i][1]), cvtpk(v[i][2], v[i][3])}; *(u32x2*)(xp + col) = xw; } const f32x4 gg = *(const f32x4*)(gnext + col);
                u32x2 wv = {cvtpk(v[i][0] * rs * gg[0], v[i][1] * rs * gg[1]), cvtpk(v[i][2] * rs * gg[2], v[i][3] * rs * gg[3])};
                *(u32x2*)(h + (size_t)tok * DM + col) = wv; }
        }
    }
}

#ifndef PROBE
#define PROBE 0
#endif
constexpr int NPHASE = 16;
__global__ void __launch_bounds__(512, 2) fwd(Args a) {
    extern __shared__ __attribute__((aligned(16))) unsigned char shm[];
    LAS unsigned char* lds = (LAS unsigned char*)shm;
    LAS unsigned char* misc = lds + LDS_MISC;
    const int tid = threadIdx.x, G = gridDim.x, bx = blockIdx.x;
    unsigned char* ws = a.ws;
    if (tid < 4) ((LAS unsigned*)misc)[tid] = 0u;
    __syncthreads();
    const int lo = a.ph_lo, hi = a.ph_hi;
    XcdBarrier bar; bar.bar = (unsigned*)(ws + WS_BAR); bar.x = 0; bar.st = nullptr;
    if (hi - lo > 1) bar = xcd_barrier_post((unsigned*)(ws + WS_BAR), (volatile LAS unsigned*)misc);
#ifndef PHMASK
#define PHMASK 0xFFFFu
#endif
#define IN(k) (((PHMASK >> (k)) & 1u) && lo <= (k) && (k) < hi)
#ifndef DBLMASK
#define DBLMASK 0u
#endif
#define REP(k) for (int rep_ = 0; rep_ < ((((DBLMASK) >> (k)) & 1u) ? 2 : 1); ++rep_)
#ifndef PROBE_T
#define PROBE_T -1
#endif
#define PT_SET(i) do { if (tid == 0) *(volatile LAS unsigned long long*)(misc + 16 + 8 * (i)) = __builtin_amdgcn_s_memrealtime(); } while (0)
#define SEAM(k) do { if (IN(k) && IN((k) + 1)) xcd_barrier(bar); if ((k) == PROBE_T) PT_SET(1); if ((k) + 1 == PROBE_T) PT_SET(0); } while (0)
    bf16_t* H = (bf16_t*)(ws + WS_H); bf16_t* PROJ = (bf16_t*)(ws + WS_PROJ); bf16_t* ATT = (bf16_t*)(ws + WS_ATT); bf16_t* XR = (bf16_t*)(ws + WS_XR);
    bf16_t* KCMP = (bf16_t*)(ws + WS_KCMP); bf16_t* VCMP = (bf16_t*)(ws + WS_VCMP);
    bf16_t* Y = (bf16_t*)(ws + WS_PROJ); bf16_t* ACT = (bf16_t*)(ws + WS_ATT);
    int* ROWS = (int*)(ws + WS_ROWS); float* TOK = (float*)(ws + WS_TOK);

    float* GATES = (float*)(ws + WS_GATES);
    if (PROBE_T == 0) PT_SET(0);
    if (IN(0)) { phase_prologue(a, lds); } SEAM(0);
    if (IN(1)) { pg8::Gemm g{H, (const bf16_t*)(ws + WS_WIN0), DM}; pg8::StaticOrder S; S.init(NTOK, 5120, G, bx); pg8::EpiBf16 E{PROJ, LDP0};
        pg8::gemm_phase(lds, g, S, E); } SEAM(1);
    if (IN(2)) { for (int it = bx; it < 256; it += G) cmp_item(lds, it, PROJ, (const bf16_t*)(ws + WS_CW1), (const bf16_t*)(ws + WS_CW2), (const float*)(ws + WS_BIAS1), a.in[4] + 128, KCMP, VCMP);
        knorm_phase(PROJ, a.in[4]);
        gates_phase(lds, H, (const bf16_t*)(ws + WS_WIN0) + (size_t)5120 * DM, GATES);
#if PROBE & 1
        for (int it = bx; it < 256; it += G) cmp_item(lds, it, PROJ, (const bf16_t*)(ws + WS_CW1), (const bf16_t*)(ws + WS_CW2), (const float*)(ws + WS_BIAS1), a.in[4] + 128, KCMP, VCMP);
        gates_phase(lds, H, (const bf16_t*)(ws + WS_WIN0) + (size_t)5120 * DM, GATES);
#endif
        } SEAM(2);
#if PROBE & 2
    if (IN(2) && IN(3)) { for (int k = 0; k < 10; ++k) xcd_barrier(bar); }
#endif
    if (IN(3)) REP(3) {
#define NSA_ITEM(u) (((((u) & 255) & 7) << 7) | (((u) >> 8) == 0 ? (((u) & 255) >> 3) : ((u) >> 8) == 1 ? 63 - (((u) & 255) >> 3) : ((u) >> 8) == 2 ? 64 + (((u) & 255) >> 3) : 127 - (((u) & 255) >> 3)))
        { int s = 0; for (int u = bx; u < 1024; u += G, ++s) { if (s == (bx & 3)) conv_jobs<1>(a, lds);
            at::nsa_item((LAS char*)lds, NSA_ITEM(u), PROJ, KCMP, VCMP, GATES, a.in[4], ATT); } }
#undef NSA_ITEM
    } SEAM(3);
    bf16_t* Z = (bf16_t*)(ws + WS_Z);
    if (IN(4)) { pg8::Gemm g{ATT, (const bf16_t*)(ws + WS_WOUT0), DM}; pg8::StaticOrder S; S.init(NTOK, DM, G, bx); pg8::EpiBf16 E{Z, DM};
        pg8::gemm_phase(lds, g, S, E); } SEAM(4);
    constexpr int CONV_T6 = 11, CONV_T7 = 5;
#define MOE_LAYER(L, p0) do { \
        unsigned* cnt = (unsigned*)(ws + WS_CNT) + 32 * (L); \
        if (IN((p0))) { if ((L) == 0) norm_route_phase<false>(lds, a.in[0], Z, a.in[2] + (L) * DM, H, (const bf16_t*)(ws + WS_WR) + (size_t)(L) * 48 * DM, a.in[12] + (L) * 4, a.in[14] + (L) * 32, cnt, ROWS, TOK); \
            else norm_route_phase<true>(lds, XR, Z, a.in[2] + (L) * DM, H, (const bf16_t*)(ws + WS_WR) + (size_t)(L) * 48 * DM, a.in[12] + (L) * 4, a.in[14] + (L) * 32, cnt, ROWS, TOK); } SEAM((p0)); \
        if (IN((p0) + 1)) { const int ntot = moe_tables(misc, cnt); \
            pg8::Gemm g{H, (const bf16_t*)(ws + WS_W1) + (size_t)(L) * 32 * 1024 * DM, DM}; \
            pg8::MoeOrder<true> S{ntot * 4, 4, G, bx, (const LAS int*)misc + 128, ROWS}; pg8::EpiSwiglu E{ACT}; \
            pg8::gemm_phase(lds, g, S, E); \
            if ((L) == 0) { const int r1 = (ntot * 4) % G; if (r1 > 0 && bx >= r1) conv_jobs<2>(a, lds, bx - r1, G - r1, CONV_T6 * (G - r1)); } } SEAM((p0) + 1); \
        if (IN((p0) + 2)) { const int ntot = moe_tables(misc, cnt); \
            pg8::Gemm g{ACT, (const bf16_t*)(ws + WS_W2) + (size_t)(L) * 32 * DM * 512, DEXP}; \
            pg8::MoeOrder<false> S{ntot * 8, 8, G, bx, (const LAS int*)misc + 128, ROWS}; pg8::EpiBf16 E{Y, DM}; \
            pg8::gemm_phase(lds, g, S, E); \
            if ((L) == 0) { const int r1 = (ntot * 4) % G, r2 = (ntot * 8) % G; const int lim6 = r1 > 0 ? CONV_T6 * (G - r1) : 0; \
                if (r2 > 0 && bx >= r2) conv_jobs<2>(a, lds, lim6 + bx - r2, G - r2, lim6 + CONV_T7 * (G - r2)); } } SEAM((p0) + 2); \
        if (IN((p0) + 3)) { (void)moe_tables(misc, cnt); \
            if ((L) == 0) combine_phase<false>(misc, TOK, Y, a.in[0], Z, XR, nullptr, a.in[1] + DM, H); else combine_phase<true>(misc, TOK, Y, XR, Z, XR, a.out, a.in[1] + DM, H); \
            } SEAM((p0) + 3); } while (0)
    MOE_LAYER(0, 5);
    if (IN(9)) { pg8::Gemm g{H, (const bf16_t*)(ws + WS_WIN1), DM}; pg8::StaticOrder S; S.init(NTOK, LDP1, G, bx); pg8::EpiBf16 E{PROJ, LDP1};
        pg8::gemm_phase(lds, g, S, E); } SEAM(9);
    int conv2_done = 0;
    if (IN(10)) { const int ntot0 = moe_tables(misc, (const unsigned*)(ws + WS_CNT)); const int r1 = (ntot0 * 4) % G, r2 = (ntot0 * 8) % G;
        conv2_done = (r1 > 0 ? CONV_T6 * (G - r1) : 0) + (r2 > 0 ? CONV_T7 * (G - r2) : 0); if (conv2_done > 6144) conv2_done = 6144; }
    if (IN(10)) REP(10) { int s = 0;
        for (int u = bx; u < 1024; u += G, ++s) { if (s == (bx & 3)) conv_jobs<2>(a, lds, conv2_done + bx, G, -1);
            at::sb_item((LAS char*)lds, (((((u & 255) & 7) + 8 * ((u >> 8) & 1)) << 6) | (((u >> 9) & 1) << 5) | ((u & 255) >> 3)), PROJ, ATT); } } SEAM(10);
    if (IN(11)) { pg8::Gemm g{ATT, (const bf16_t*)(ws + WS_WOUT1), DM}; pg8::StaticOrder S; S.init(NTOK, DM, G, bx); pg8::EpiBf16 E{Z, DM};
        pg8::gemm_phase(lds, g, S, E); } SEAM(11);
    MOE_LAYER(1, 12);
#undef MOE_LAYER
    if (PROBE_T >= 0 && bx == 0 && tid == 0) { if (PROBE_T == NPHASE - 1) PT_SET(1);
        const unsigned long long d_ = (*(volatile LAS unsigned long long*)(misc + 24) - *(volatile LAS unsigned long long*)(misc + 16)) * 9ull, s_ = __builtin_amdgcn_s_memrealtime();
        while (__builtin_amdgcn_s_memrealtime() - s_ < d_) __builtin_amdgcn_s_sleep(8); }
#undef IN
#undef SEAM
}

extern "C" void kernel_launch(void* const* d_in, const int* in_sizes, int n_in, void* d_out, int out_size, void* d_ws, size_t ws_size, hipStream_t stream) {
    static int grid = 0;
    if (grid == 0) {
        if (n_in != 18 || out_size != NTOK * DM || ws_size < WS_END) { fprintf(stderr, "kernel_launch: unexpected shapes (n_in %d out %d ws %zu need %zu)\n", n_in, out_size, ws_size, (size_t)WS_END); grid = -1; return; }
        int dev = 0, cus = 0, per_cu = 0;
        if (hipGetDevice(&dev) != hipSuccess || hipDeviceGetAttribute(&cus, hipDeviceAttributeMultiprocessorCount, dev) != hipSuccess) { grid = -1; return; }
        if (hipFuncSetAttribute((const void*)fwd, hipFuncAttributeMaxDynamicSharedMemorySize, LDS_BYTES) != hipSuccess) { fprintf(stderr, "kernel_launch: hipFuncSetAttribute failed\n"); grid = -1; return; }
        if (hipOccupancyMaxActiveBlocksPerMultiprocessor(&per_cu, (const void*)fwd, 512, LDS_BYTES) != hipSuccess || per_cu < 1) { fprintf(stderr, "kernel_launch: occupancy query says %d\n", per_cu); }
        (void)hipGetLastError();
        grid = cus;
    }
    if (grid < 0) return;
    (void)hipMemsetAsync((char*)d_ws, 0, WS_ZERO_BYTES, stream);
    Args a{};
    for (int i = 0; i < 18; ++i) a.in[i] = (const float*)d_in[i];
    a.out = (float*)d_out; a.ws = (unsigned char*)d_ws;
#ifndef ONE_LAUNCH
#define ONE_LAUNCH 1
#endif
    if (ONE_LAUNCH) { a.ph_lo = 0; a.ph_hi = NPHASE; hipLaunchKernelGGL(fwd, dim3(grid), dim3(512), LDS_BYTES, stream, a); }
    else for (int p = 0; p < NPHASE; ++p) { a.ph_lo = p; a.ph_hi = p + 1; hipLaunchKernelGGL(fwd, dim3(grid), dim3(512), LDS_BYTES, stream, a); }
}
```

```cpp
#include <hip/hip_runtime.h>
#include <stdint.h>
#include <stdio.h>

#define LAS __attribute__((address_space(3)))
#define DI __device__ __forceinline__
typedef unsigned short bf16_t;
typedef short bf16x8 __attribute__((ext_vector_type(8)));
typedef short s16x4 __attribute__((ext_vector_type(4)));
typedef float f32x4 __attribute__((ext_vector_type(4)));
typedef float f32x2 __attribute__((ext_vector_type(2)));
typedef float f32x16 __attribute__((ext_vector_type(16)));
typedef unsigned u32x4 __attribute__((ext_vector_type(4)));
typedef unsigned u32x2 __attribute__((ext_vector_type(2)));

constexpr int T_ = 8192, B_ = 2, NTOK = B_ * T_, DM = 2048, HD = 128, NH = 16, NKV = 4;
constexpr int LDP0 = 5376;
constexpr int C_Q = 0, C_KC = 2048, C_VC = 2560, C_KS = 3072, C_VS = 3584, C_KW = 4096, C_VW = 4608, C_GT = 5120;
constexpr int LDP1 = 6144;
constexpr int NEXP = 32, DEXP = 512;
constexpr int MAXTILES = 160;
constexpr float LOG2E = 1.4426950408889634f;
constexpr float QSCALE = 0.08838834764831845f;

constexpr size_t WS_BAR   = 0;
constexpr size_t WS_CNT   = 16384;
constexpr size_t WS_ZERO_BYTES = 90112;
constexpr size_t WS_FLAG  = 65536;
constexpr size_t WS_BIAS1 = 32768;
constexpr size_t WS_WIN0  = 1u << 20;
constexpr size_t WS_WOUT0 = WS_WIN0 + (size_t)LDP0 * DM * 2;
constexpr size_t WS_WIN1  = WS_WOUT0 + (size_t)DM * DM * 2;
constexpr size_t WS_WOUT1 = WS_WIN1 + (size_t)LDP1 * DM * 2;
constexpr size_t WS_WR    = WS_WOUT1 + (size_t)DM * DM * 2;
constexpr size_t WS_W1    = WS_WR + (size_t)2 * 256 * DM * 2;
constexpr size_t WS_W2    = WS_W1 + (size_t)2 * 32 * 1024 * DM * 2;
constexpr size_t WS_CW1   = WS_W2 + (size_t)2 * 32 * DM * 512 * 2;
constexpr size_t WS_CW2   = WS_CW1 + (size_t)2 * 128 * 4096 * 2;
constexpr size_t WS_H     = WS_CW2 + (size_t)2 * 128 * 128 * 2;
constexpr size_t WS_PROJ  = WS_H + (size_t)NTOK * DM * 2;
constexpr size_t WS_ATT   = WS_PROJ + (size_t)NTOK * LDP1 * 2;
constexpr size_t WS_XR    = WS_ATT + (size_t)NTOK * DM * 2;
constexpr size_t WS_KCMP  = WS_XR + (size_t)NTOK * DM * 4;
constexpr size_t WS_VCMP  = WS_KCMP + (size_t)2 * 4 * 512 * 128 * 2;
constexpr size_t WS_ROWS  = WS_VCMP + (size_t)2 * 4 * 512 * 128 * 2;
constexpr size_t WS_TOK   = WS_ROWS + (size_t)32 * 16384 * 4;
constexpr size_t WS_GATES = WS_TOK + (size_t)NTOK * 32;
constexpr size_t WS_Z     = WS_GATES + (size_t)NTOK * 48 * 4;
constexpr size_t WS_END   = WS_Z + (size_t)NTOK * DM * 2;

constexpr int LDS_STAGE = 131072;
constexpr int LDS_MISC  = 144384;
constexpr int LDS_BYTES = 144384 + 4096;

DI unsigned cvtpk(float lo, float hi) { unsigned r; asm volatile("v_cvt_pk_bf16_f32 %0, %1, %2" : "=v"(r) : "v"(lo), "v"(hi)); return r; }
DI float bflo(unsigned w) { return __uint_as_float(w << 16); }
DI float bfhi(unsigned w) { return __uint_as_float(w & 0xffff0000u); }
DI float wave_sum(float v) { for (int o = 32; o >= 1; o >>= 1) v += __shfl_xor(v, o); return v; }
DI unsigned cvt4_fp8(float a, float b, float c, float d, float sc) {
    a = __builtin_amdgcn_fmed3f(a * sc, -448.f, 448.f); b = __builtin_amdgcn_fmed3f(b * sc, -448.f, 448.f); c = __builtin_amdgcn_fmed3f(c * sc, -448.f, 448.f); d = __builtin_amdgcn_fmed3f(d * sc, -448.f, 448.f);
    int w = 0; w = __builtin_amdgcn_cvt_pk_fp8_f32(a, b, w, false); w = __builtin_amdgcn_cvt_pk_fp8_f32(c, d, w, true); return (unsigned)w; }
DI u32x2 cvt8_fp8(u32x4 w, float sc) { u32x2 o; o.x = cvt4_fp8(bflo(w.x), bfhi(w.x), bflo(w.y), bfhi(w.y), sc); o.y = cvt4_fp8(bflo(w.z), bfhi(w.z), bflo(w.w), bfhi(w.w), sc); return o; }
typedef __attribute__((address_space(1))) unsigned gu32;
typedef __attribute__((address_space(1))) unsigned long long gu64;
#define RLX_AGENT __ATOMIC_RELAXED, __HIP_MEMORY_SCOPE_AGENT
DI bf16x8 pack8(f32x4 a, f32x4 b) { u32x4 w = {cvtpk(a[0], a[1]), cvtpk(a[2], a[3]), cvtpk(b[0], b[1]), cvtpk(b[2], b[3])}; return __builtin_bit_cast(bf16x8, w); }

#define XB_TMO      128
#define XB_XCNT(j)  (256  + 64 * (j))
#define XB_XSUB(j)  (1280 + 64 * (j))
#define XB_XGEN(j)  (2304 + 64 * (j))
#define XB_TOP      3328
#define XB_TOPGEN   3392
#define XCD_BAR_WORDS 3456
#define XB_SPIN_CAP (1u << 18)
__device__ __forceinline__ unsigned xb_ld(unsigned* p)              { return __hip_atomic_load(p, __ATOMIC_RELAXED, __HIP_MEMORY_SCOPE_AGENT); }
__device__ __forceinline__ unsigned xb_add(unsigned* p, unsigned v) { return __hip_atomic_fetch_add(p, v, __ATOMIC_RELAXED, __HIP_MEMORY_SCOPE_AGENT); }
__device__ __forceinline__ unsigned xb_xcc_id() { return (unsigned)__builtin_amdgcn_s_getreg((3 << 11) | 20) & 0xFu; }
#define XB_SPIN(cond, bar) do { unsigned _sp = 0; while (cond) { __builtin_amdgcn_s_sleep(1); \
    if ((++_sp & 255u) == 0u) { if (xb_ld(&(bar)[XB_TMO])) break; if (_sp > XB_SPIN_CAP) { atomicAdd(&(bar)[XB_TMO], 1u); break; } } } } while (0)
struct XcdBarrier { unsigned* bar; unsigned x; volatile LAS unsigned* st; };
__device__ __forceinline__ XcdBarrier xcd_barrier_post(unsigned* bar, volatile LAS unsigned* st) {
    XcdBarrier b; b.bar = bar; b.x = xb_xcc_id(); b.st = st;
    if (threadIdx.x == 0) (void)xb_add(&bar[XB_XCNT(b.x)], 1u);
    return b;
}
__device__ __forceinline__ void xcd_barrier_complete(unsigned* bar, unsigned x, unsigned& nloc, unsigned& nx) {
    const unsigned G = gridDim.x * gridDim.y * gridDim.z;
    unsigned sum, cnt, mine, sp = 0u;
    for (;;) {
        sum = 0u; cnt = 0u; mine = 0u;
#pragma unroll
        for (unsigned j = 0; j < 16; ++j) { const unsigned c = xb_ld(&bar[XB_XCNT(j)]); sum += c; cnt += (c > 0u) ? 1u : 0u; mine = (j == x) ? c : mine; }
        if (sum == G) break;
        __builtin_amdgcn_s_sleep(1);
        if ((++sp & 255u) == 0u) { if (xb_ld(&bar[XB_TMO])) break; if (sp > XB_SPIN_CAP) { atomicAdd(&bar[XB_TMO], 1u); break; } }
    }
    nloc = mine > 0u ? mine : 1u; nx = cnt > 0u ? cnt : 1u;
}
__device__ __forceinline__ void xcd_barrier(const XcdBarrier& b) {
    asm volatile("s_waitcnt vmcnt(0)" ::: "memory");
    __syncthreads();
    if (threadIdx.x == 0) {
        unsigned* bar = b.bar;
        __builtin_amdgcn_s_waitcnt(0);
        unsigned nloc = b.st[0], nx = b.st[1];
        if (nloc == 0u) { xcd_barrier_complete(bar, b.x, nloc, nx); b.st[0] = nloc; b.st[1] = nx; }
        const unsigned old = xb_add(&bar[XB_XSUB(b.x)], 1u);
        const unsigned gen = old / nloc;
        if (old + 1u == (gen + 1u) * nloc) {
            __builtin_amdgcn_fence(__ATOMIC_RELEASE, "agent");
            asm volatile("s_waitcnt vmcnt(0)" ::: "memory");
            const unsigned og = xb_add(&bar[XB_TOP], 1u);
            const unsigned tg = og / nx;
            if (og + 1u == (tg + 1u) * nx) xb_add(&bar[XB_TOPGEN], 1u);
            else XB_SPIN(xb_ld(&bar[XB_TOPGEN]) == tg, bar);
            __builtin_amdgcn_fence(__ATOMIC_ACQUIRE, "agent");
            xb_add(&bar[XB_XGEN(b.x)], 1u);
            asm volatile("s_waitcnt vmcnt(0)" ::: "memory");
        } else {
            XB_SPIN(xb_ld(&bar[XB_XGEN(b.x)]) == gen, bar);
            __builtin_amdgcn_fence(__ATOMIC_ACQUIRE, "agent");
            asm volatile("s_waitcnt vmcnt(0)" ::: "memory");
        }
    }
    __syncthreads();
}

namespace pg8 {
constexpr int BM = 256, BK = 64, HALF = 128, HTB = HALF * BK * 2, STAGE_BYTES = 8 * HTB, NXCD = 8, WGM = 8;
DI int lds_byte(int r, int c) { const int st = (r >> 4) * 2 + (c >> 5), rr = r & 15, cc = c & 31, ob = rr * 64 + cc * 2; return st * 1024 + (ob ^ (((ob >> 9) & 1) << 5)); }
DI void stage_rc(int b, int& R, int& C) { const int st = b / 1024, sb = b % 1024, swz = sb ^ (((sb >> 9) & 1) << 5); R = (st >> 1) * 16 + swz / 64; C = (st & 1) * 32 + (swz % 64) / 2; }
DI int perm32(int rho) { const int n = rho >> 4, i = rho & 15; return 8 * (i >> 2) + 4 * n + (i & 3); }
typedef int i32x8 __attribute__((ext_vector_type(8)));
typedef int i32x4v __attribute__((ext_vector_type(4)));
DI i32x8 cat8(bf16x8 a, bf16x8 b) { return __builtin_shufflevector(__builtin_bit_cast(i32x4v, a), __builtin_bit_cast(i32x4v, b), 0, 1, 2, 3, 4, 5, 6, 7); }
struct Unit { int pm, pn, pb; };
struct Gemm { const bf16_t* A; const bf16_t* Bt; int K; int sa, sb; };

struct StaticOrder {
    static constexpr bool PUBLISH = false, WAITS = false;
    DI void done(const Unit&) const {}
    DI void publish(int) const {}
    int nM, nN, nwg, G, c;
    DI void init(int M, int N, int G_, int c_) { nM = M / BM; nN = N / BM; nwg = nM * nN; G = G_; c = c_; }
    DI bool next(int i, Unit& u, unsigned = 0u) const {
        const long L = (long)i * G + c; if (L >= nwg) return false;
        int wgid = (int)L; { const int q = nwg / NXCD, r = nwg % NXCD, xcd = wgid % NXCD, off = wgid / NXCD; wgid = (xcd < r ? xcd * (q + 1) : r * (q + 1) + (xcd - r) * q) + off; }
        const int nig = WGM * nN, gid = wgid / nig, fm = gid * WGM, gsz = (nM - fm) < WGM ? (nM - fm) : WGM;
        u.pm = fm + ((wgid % nig) % gsz); u.pn = (wgid % nig) / gsz; u.pb = u.pn; return true;
    }
    DI int arow(const Unit& u, int r) const { return u.pm * BM + r; }
};
template <bool GATHER> struct MoeOrder {
    static constexpr bool PUBLISH = GATHER, WAITS = !GATHER;
    int ntot, nct, G, c; const LAS int* tinfo; const int* rows; unsigned* flags; int rem1, qh;
    DI void publish(int pm) const { __hip_atomic_fetch_add((gu32*)(flags + pm * 16), 1u, RLX_AGENT); }
    DI void done(const Unit& u) const {
        asm volatile("s_waitcnt vmcnt(0)" ::: "memory");
        __builtin_amdgcn_s_barrier(); __builtin_amdgcn_s_barrier();
        if (threadIdx.x == 0) __hip_atomic_fetch_add((gu32*)(flags + u.pm * 16), 1u, RLX_AGENT);
    }
    DI bool locate(int i, int& Lout) const {
        int L;
        if (!GATHER && G == 256) {
            const int q2 = ntot >> 3, x = c & 7, w = c >> 3; int hx = (rem1 + 7 - x) >> 3; if (hx >= 32) hx = 0;
            int pos;
            if (i < qh) pos = i * 32 + w; else { if (w < hx) return false; pos = qh * 32 + (i - qh) * (32 - hx) + (w - hx); }
            if (pos >= q2) return false;
            L = x * q2 + pos;
        } else {
        const int L0 = i * G + c; if (L0 >= ntot) return false;
        L = L0; { const int q = ntot / NXCD, r = ntot % NXCD, xcd = L0 % NXCD, off = L0 / NXCD; L = (xcd < r ? xcd * (q + 1) : r * (q + 1) + (xcd - r) * q) + off; }
        }
        Lout = L; return true;
    }
    DI bool next(int i, Unit& u, unsigned pf = 0u) const {
        int L; if (!locate(i, L)) return false;
        const int rt = L / nct, pn = L - rt * nct; u.pm = rt; u.pn = pn; u.pb = tinfo[rt * 4] * nct + pn;
        if constexpr (!GATHER) { if (__builtin_amdgcn_readfirstlane(threadIdx.x >> 6) == 0) {
            gu32* f = (gu32*)(flags + rt * 16);
            if ((unsigned)__builtin_amdgcn_readfirstlane(pf) < 4u)
                for (unsigned spins = 0; (unsigned)__builtin_amdgcn_readfirstlane(__hip_atomic_load(f, RLX_AGENT)) < 4u && spins < (1u << 18); ++spins) __builtin_amdgcn_s_sleep(1);
            __builtin_amdgcn_fence(__ATOMIC_ACQUIRE, "agent"); } }
        return true;
    }
    DI unsigned flag_peek(int i) const {
        int L; unsigned v = 0u;
        if (__builtin_amdgcn_readfirstlane(threadIdx.x >> 6) == 0 && locate(i, L)) v = __hip_atomic_load((gu32*)(flags + (L / nct) * 16), RLX_AGENT);
        return v;
    }
    DI int arow(const Unit& u, int r) const {
        if constexpr (GATHER) { const int base = tinfo[u.pm * 4 + 1], nv = tinfo[u.pm * 4 + 2]; return r < nv ? rows[base + r] : 0; }
        else return u.pm * BM + r;
    }
};

struct EpiBf16 {
    static constexpr bool PERM = true;
    bf16_t* O; int ldc;
    DI void operator()(const f32x4 (&acc)[2][2][4][2], const Unit& u, int wr, int wc, int fr, int fq) const {
        const int row0 = u.pm * BM + wr * 64 + fr, col0 = u.pn * BM + wc * 32 + 8 * fq;
#pragma unroll
        for (int ai = 0; ai < 2; ++ai)
#pragma unroll
            for (int m = 0; m < 4; ++m) { bf16_t* rowp = O + (size_t)(row0 + ai * HALF + m * 16) * ldc + col0;
#pragma unroll
                for (int bj = 0; bj < 2; ++bj) { const f32x4 v0 = acc[ai][bj][m][0], v1 = acc[ai][bj][m][1];
                    u32x4 w; w.x = cvtpk(v0[0], v0[1]); w.y = cvtpk(v0[2], v0[3]); w.z = cvtpk(v1[0], v1[1]); w.w = cvtpk(v1[2], v1[3]);
                    *(u32x4*)(rowp + bj * HALF) = w; } }
    }
};
struct EpiF8 {
    static constexpr bool PERM = true;
    unsigned char* O; int ldc; float sc;
    DI void operator()(const f32x4 (&acc)[2][2][4][2], const Unit& u, int wr, int wc, int fr, int fq) const {
        const int row0 = u.pm * BM + wr * 64 + fr, col0 = u.pn * BM + wc * 32 + 8 * fq;
#pragma unroll
        for (int ai = 0; ai < 2; ++ai)
#pragma unroll
            for (int m = 0; m < 4; ++m) { unsigned char* rowp = O + (size_t)(row0 + ai * HALF + m * 16) * ldc + col0;
#pragma unroll
                for (int bj = 0; bj < 2; ++bj) { const f32x4 v0 = acc[ai][bj][m][0], v1 = acc[ai][bj][m][1];
                    u32x2 w; w.x = cvt4_fp8(v0[0], v0[1], v0[2], v0[3], sc); w.y = cvt4_fp8(v1[0], v1[1], v1[2], v1[3], sc);
                    *(u32x2*)(rowp + bj * HALF) = w; } }
    }
};
struct EpiF32 {
    static constexpr bool PERM = false;
    const float* base; float* C; int ldc;
    DI void operator()(const f32x4 (&acc)[2][2][4][2], const Unit& u, int wr, int wc, int fr, int fq) const {
        const int row0 = u.pm * BM + wr * 64 + fr, col0 = u.pn * BM + wc * 32 + 4 * fq;
#pragma unroll
        for (int ai = 0; ai < 2; ++ai)
#pragma unroll
            for (int m = 0; m < 4; ++m) { const size_t off = (size_t)(row0 + ai * HALF + m * 16) * ldc + col0;
#pragma unroll
                for (int bj = 0; bj < 2; ++bj)
#pragma unroll
                    for (int n = 0; n < 2; ++n) { f32x4 v = acc[ai][bj][m][n]; if (base) v += *(const f32x4*)(base + off + bj * HALF + n * 16);
                        *(f32x4*)(C + off + bj * HALF + n * 16) = v; } }
    }
};
struct EpiSwiglu {
    static constexpr bool PERM = true;
    bf16_t* O;
    DI void operator()(const f32x4 (&acc)[2][2][4][2], const Unit& u, int wr, int wc, int fr, int fq) const {
        const int row0 = u.pm * BM + wr * 64 + fr, col0 = u.pn * HALF + wc * 32 + 8 * fq;
#pragma unroll
        for (int ai = 0; ai < 2; ++ai)
#pragma unroll
            for (int m = 0; m < 4; ++m) { bf16_t* rowp = O + (size_t)(row0 + ai * HALF + m * 16) * DEXP + col0;
                float h[8];
#pragma unroll
                for (int n = 0; n < 2; ++n)
#pragma unroll
                    for (int j = 0; j < 4; ++j) { const float gt = acc[ai][0][m][n][j], up = acc[ai][1][m][n][j];
                        h[n * 4 + j] = gt * __builtin_amdgcn_rcpf(1.0f + __builtin_amdgcn_exp2f(-gt * LOG2E)) * up; }
                u32x4 w; w.x = cvtpk(h[0], h[1]); w.y = cvtpk(h[2], h[3]); w.z = cvtpk(h[4], h[5]); w.w = cvtpk(h[6], h[7]);
                *(u32x4*)rowp = w; }
    }
};

struct EpiSwiglu8 {
    static constexpr bool PERM = true;
    unsigned char* O;
    DI void operator()(const f32x4 (&acc)[2][2][4][2], const Unit& u, int wr, int wc, int fr, int fq) const {
        const int row0 = u.pm * BM + wr * 64 + fr, col0 = u.pn * HALF + wc * 32 + 8 * fq;
#pragma unroll
        for (int ai = 0; ai < 2; ++ai)
#pragma unroll
            for (int m = 0; m < 4; ++m) { unsigned char* rowp = O + (size_t)(row0 + ai * HALF + m * 16) * DEXP + col0;
                float h[8];
#pragma unroll
                for (int n = 0; n < 2; ++n)
#pragma unroll
                    for (int j = 0; j < 4; ++j) { const float gt = acc[ai][0][m][n][j], up = acc[ai][1][m][n][j];
                        h[n * 4 + j] = gt * __builtin_amdgcn_rcpf(1.0f + __builtin_amdgcn_exp2f(-gt * LOG2E)) * up; }
                const unsigned w0 = cvt4_fp8(h[0], h[1], h[2], h[3], 8.f), w1 = cvt4_fp8(h[4], h[5], h[6], h[7], 8.f);
                __hip_atomic_store((gu64*)rowp, (unsigned long long)w0 | ((unsigned long long)w1 << 32), RLX_AGENT); }
    }
};

template <bool F8 = false, class Epi, class Sched>
DI void gemm_phase(LAS unsigned char* lds, const Gemm g, const Sched& S, const Epi& E) {
    const int tid = threadIdx.x, wid = __builtin_amdgcn_readfirstlane(tid >> 6), lane = tid & 63, wr = wid >> 2, wc = wid & 3, fr = lane & 15, fq = lane >> 4;
    const int K = g.K, nt = K / BK;
    int Ra[2]; unsigned Ca[2], voffB[2];
#pragma unroll
    for (int i = 0; i < 2; ++i) { int R, C; stage_rc(tid * 16 + i * 8192, R, C); const int Rb = Epi::PERM ? ((R & ~31) + perm32(R & 31)) : R;
        Ra[i] = R; Ca[i] = (unsigned)C * 2u; voffB[i] = (unsigned)(Rb * K + C) * 2u; }
    const unsigned rowB = (unsigned)K * 2u;
    const size_t kstep = (size_t)(BK * 2);
    const size_t hstep = (size_t)HALF * K * 2;
    const size_t tstep = 2 * hstep;
    const unsigned ldsw = (unsigned)wid * 1024u;
    const int aoff = lds_byte(wr * 64 + fr, fq * 8), boff = lds_byte(wc * 32 + fr, fq * 8);
#define PG8_SA(b, h) (((b) * 2 + (h)) * HTB)
#define PG8_SB(b, h) ((4 + (b) * 2 + (h)) * HTB)
#define PG8_STAGE(bufoff, gbase, voff) do { _Pragma("unroll") for (int _i = 0; _i < 2; ++_i) \
        __builtin_amdgcn_global_load_lds((const unsigned*)((const char*)(gbase) + (voff)[_i]), (LAS unsigned*)(lds + (bufoff) + ldsw + _i * 8192), 16, 0, 0); } while (0)
#define PG8_LDA(dst, b, h) do { _Pragma("unroll") for (int m = 0; m < 4; ++m) _Pragma("unroll") for (int k = 0; k < 2; ++k) dst[m][k] = *(const LAS bf16x8*)(lds + PG8_SA(b, h) + aoff + m * 2048 + k * 1024); } while (0)
#define PG8_LDB(dst, b, h) do { _Pragma("unroll") for (int n = 0; n < 2; ++n) _Pragma("unroll") for (int k = 0; k < 2; ++k) dst[n][k] = *(const LAS bf16x8*)(lds + PG8_SB(b, h) + boff + n * 2048 + k * 1024); } while (0)
#define PG8_MMA(ai, bj, At, Bt) do { __builtin_amdgcn_s_setprio(1); _Pragma("unroll") for (int m = 0; m < 4; ++m) _Pragma("unroll") for (int n = 0; n < 2; ++n) { \
        if constexpr (F8) asm volatile("v_mfma_scale_f32_16x16x128_f8f6f4 %0, %1, %2, %0, %3, %4 op_sel_hi:[0,0,0]" : "+v"(acc[ai][bj][m][n]) : "v"(cat8(Bt[n][0], Bt[n][1])), "v"(cat8(At[m][0], At[m][1])), "v"(g.sb), "v"(g.sa)); \
        else { _Pragma("unroll") for (int k = 0; k < 2; ++k) acc[ai][bj][m][n] = __builtin_amdgcn_mfma_f32_16x16x32_bf16(Bt[n][k], At[m][k], acc[ai][bj][m][n], 0, 0, 0); } } __builtin_amdgcn_s_setprio(0); } while (0)
#define PG8_WAIT_V(n) asm volatile("s_waitcnt vmcnt(" #n ")" ::: "memory")
#define PG8_WAIT_L(n) asm volatile("s_waitcnt lgkmcnt(" #n ")" ::: "memory")
#define PG8_BAR __builtin_amdgcn_s_barrier()
#define PG8_SCHED __builtin_amdgcn_sched_barrier(0)
#define PG8_MKVA(dst, u) do { _Pragma("unroll") for (int _h = 0; _h < 2; ++_h) _Pragma("unroll") for (int _i = 0; _i < 2; ++_i) \
        dst[_h][_i] = (unsigned)S.arow(u, _h * HALF + Ra[_i]) * rowB + Ca[_i]; } while (0)
    Unit cur, nxt; int ui = 0;
    if (!S.next(0, cur)) return;
    if constexpr (Sched::WAITS) PG8_BAR;
    f32x4 acc[2][2][4][2];
#pragma unroll
    for (int a = 0; a < 2; ++a)
#pragma unroll
        for (int b = 0; b < 2; ++b)
#pragma unroll
            for (int m = 0; m < 4; ++m)
#pragma unroll
                for (int n = 0; n < 2; ++n) acc[a][b][m][n] = (f32x4){0.f, 0.f, 0.f, 0.f};
    bf16x8 At[4][2], B0[2][2], B1[2][2];
    const char* Ab = (const char*)g.A;
    unsigned va[2][2], nva[2][2];
    PG8_MKVA(va, cur);
    const char* cB = (const char*)g.Bt + (size_t)cur.pb * tstep;
    PG8_STAGE(PG8_SB(0, 0), cB, voffB); PG8_STAGE(PG8_SA(0, 0), Ab, va[0]); PG8_STAGE(PG8_SB(0, 1), cB + hstep, voffB); PG8_STAGE(PG8_SA(0, 1), Ab, va[1]);
    if (wr == 1) PG8_BAR;
    PG8_WAIT_V(4); PG8_BAR;
    PG8_STAGE(PG8_SB(1, 0), cB + kstep, voffB); PG8_STAGE(PG8_SA(1, 0), Ab + kstep, va[0]); PG8_STAGE(PG8_SB(1, 1), cB + hstep + kstep, voffB);
    PG8_WAIT_V(6); PG8_BAR;
    unsigned pf = 0u; int pend = -1;
    for (;;) {
        const bool has_next = S.next(ui + 1, nxt, pf);
        if (has_next) { PG8_MKVA(nva, nxt); } else {
#pragma unroll
            for (int h = 0; h < 2; ++h)
#pragma unroll
                for (int i = 0; i < 2; ++i) nva[h][i] = va[h][i]; }
        const char* nB = has_next ? (const char*)g.Bt + (size_t)nxt.pb * tstep : cB;
        for (int t = 0; t < nt; t += 2) {
            if constexpr (Sched::PUBLISH) {
                if (t == 2 && pend >= 0) { if (tid == 0) S.publish(pend); pend = -1; } }
            const bool last = (t == nt - 2);
            const char* a1 = Ab + (size_t)(t + 1) * kstep;
            const char* a2 = last ? Ab : Ab + (size_t)(t + 2) * kstep; const char* b2 = last ? nB : cB + (size_t)(t + 2) * kstep;
            const char* a3 = a2 + kstep; const char* b3 = b2 + kstep;
            unsigned xa[2][2];
#pragma unroll
            for (int h = 0; h < 2; ++h)
#pragma unroll
                for (int i = 0; i < 2; ++i) xa[h][i] = last ? nva[h][i] : va[h][i];
            PG8_LDB(B0, 0, 0); PG8_SCHED; PG8_LDA(At, 0, 0); PG8_STAGE(PG8_SA(1, 1), a1, va[1]);
            PG8_WAIT_L(8); PG8_BAR; PG8_WAIT_L(0); PG8_MMA(0, 0, At, B0); PG8_BAR; PG8_SCHED;
            PG8_LDB(B1, 0, 1); PG8_STAGE(PG8_SB(0, 0), b2, voffB);
            PG8_BAR; PG8_WAIT_L(0); PG8_MMA(0, 1, At, B1); PG8_BAR;
            PG8_LDA(At, 0, 1); PG8_STAGE(PG8_SA(0, 0), a2, xa[0]);
            PG8_BAR; PG8_WAIT_L(0); PG8_MMA(1, 0, At, B0); PG8_BAR; PG8_SCHED;
            PG8_STAGE(PG8_SB(0, 1), b2 + hstep, voffB);
            PG8_WAIT_V(6); PG8_BAR; PG8_MMA(1, 1, At, B1); PG8_BAR;
            PG8_LDB(B0, 1, 0); PG8_SCHED; PG8_LDA(At, 1, 0); PG8_STAGE(PG8_SA(0, 1), a2, xa[1]);
            PG8_WAIT_L(8); PG8_BAR; PG8_WAIT_L(0); PG8_MMA(0, 0, At, B0); PG8_BAR; PG8_SCHED;
            PG8_LDB(B1, 1, 1); PG8_STAGE(PG8_SB(1, 0), b3, voffB);
            PG8_BAR; PG8_WAIT_L(0); PG8_MMA(0, 1, At, B1); PG8_BAR;
            PG8_LDA(At, 1, 1); PG8_STAGE(PG8_SA(1, 0), a3, xa[0]);
            PG8_BAR; PG8_WAIT_L(0); PG8_MMA(1, 0, At, B0); PG8_BAR; PG8_SCHED;
            PG8_STAGE(PG8_SB(1, 1), b3 + hstep, voffB);
            PG8_WAIT_V(6); PG8_BAR; PG8_MMA(1, 1, At, B1); PG8_BAR;
        }
        if constexpr (Sched::WAITS) pf = S.flag_peek(ui + 2);
        if constexpr (F8) asm volatile("s_nop 15\n\ts_nop 15" ::: "memory");
        E(acc, cur, wr, wc, fr, fq);
        if constexpr (Sched::PUBLISH) { if (has_next) pend = __builtin_amdgcn_readfirstlane(cur.pm); else S.done(cur); }
        if (!has_next) break;
#pragma unroll
        for (int a = 0; a < 2; ++a)
#pragma unroll
            for (int b = 0; b < 2; ++b)
#pragma unroll
                for (int m = 0; m < 4; ++m)
#pragma unroll
                    for (int n = 0; n < 2; ++n) acc[a][b][m][n] = (f32x4){0.f, 0.f, 0.f, 0.f};
        cur = nxt; cB = nB; ++ui;
#pragma unroll
        for (int h = 0; h < 2; ++h)
#pragma unroll
            for (int i = 0; i < 2; ++i) va[h][i] = nva[h][i];
    }
    PG8_WAIT_V(0);
    if (wr == 0) PG8_BAR;
    PG8_BAR;
#undef PG8_SA
#undef PG8_SB
#undef PG8_STAGE
#undef PG8_LDA
#undef PG8_LDB
#undef PG8_MMA
#undef PG8_WAIT_V
#undef PG8_WAIT_L
#undef PG8_BAR
#undef PG8_SCHED
#undef PG8_MKVA
}
}

namespace at {
constexpr int SHM = 16384;
constexpr int STG_W = 32 * 272;
constexpr int L_K = 0, L_V = 2 * SHM, L_STG = 4 * SHM, L_WS = L_STG + 8 * STG_W, L_SEL = L_WS + 8 * 512, L_UNI = L_SEL + 1024, L_FLAG = L_UNI + 64;
static_assert(L_FLAG + 128 <= LDS_MISC, "attention LDS map");
#define KSWZ(row, colB) ((row) * 256 + ((colB) ^ (((row) & 7) << 4)))
#define SBAR() __builtin_amdgcn_sched_barrier(0)
DI int v_st(int k, int c) { const int kk = (k & ~0xC) | ((k & 4) << 1) | ((k & 8) >> 1); return ((kk >> 3) * 4 + (c >> 5)) * 512 + ((kk & 7) * 32 + (c & 31)) * 2; }
DI int v_rd_base(int lane) { return ((lane & 3) << 3) | (((lane >> 2) & 3) << 6) | (((lane >> 4) & 1) << 5) | (((lane >> 5) & 1) << 8); }
constexpr int v_rd_off(int d0, int ks, int half) { return d0 * 512 + ks * 4096 + half * 2048; }
DI int crow(int r, int hi) { return (r & 3) + 8 * (r >> 2) + 4 * hi; }

template <bool BIAS = false> DI void qkt(f32x16& p0, f32x16& p1, const LAS char* K_lds, int r32, int hi, const bf16x8* qr, float slope = 0.f) {
    if (BIAS) {
#pragma unroll
        for (int r = 0; r < 16; ++r) { const float v = slope * (float)((r & 3) + 8 * (r >> 2)); p0[r] = v; p1[r] = v; } }
    else { p0 = f32x16{}; p1 = f32x16{}; }
    const LAS char* kb[4];
#pragma unroll
    for (int dd = 0; dd < 4; ++dd) kb[dd] = K_lds + KSWZ(r32, (dd * 16 + hi * 8) * 2);
#pragma unroll
    for (int d0 = 0; d0 < 8; ++d0) { const LAS char* a = kb[d0 & 3] + (d0 >> 2) * 128;
        const bf16x8 b0 = *(const LAS bf16x8*)a;
        const bf16x8 b1 = *(const LAS bf16x8*)(a + 32 * 256);
        p0 = __builtin_amdgcn_mfma_f32_32x32x16_bf16(b0, qr[d0], p0, 0, 0, 0);
        p1 = __builtin_amdgcn_mfma_f32_32x32x16_bf16(b1, qr[d0], p1, 0, 0, 0); }
}
DI void pv_tile(f32x16* o, int vb0, bf16x8 pa0, bf16x8 pa1, bf16x8 pa2, bf16x8 pa3) {
#define TRRD(dst, off) asm volatile("ds_read_b64_tr_b16 %0, %1 offset:%2" : "=&v"(dst) : "v"(vb0), "i"(off) : "memory")
#define PV_D0(d0) do { s16x4 l0, l1, l2, l3, h0, h1, h2, h3; constexpr int b_ = v_rd_off(d0, 0, 0); \
        TRRD(l0, b_); TRRD(h0, b_ + 2048); TRRD(l1, b_ + 4096); TRRD(h1, b_ + 6144); TRRD(l2, b_ + 8192); TRRD(h2, b_ + 10240); TRRD(l3, b_ + 12288); TRRD(h3, b_ + 14336); \
        asm volatile("s_waitcnt lgkmcnt(0)" ::: "memory"); SBAR(); \
        o[d0] = __builtin_amdgcn_mfma_f32_32x32x16_bf16(pa0, (bf16x8){l0[0], l0[1], l0[2], l0[3], h0[0], h0[1], h0[2], h0[3]}, o[d0], 0, 0, 0); \
        o[d0] = __builtin_amdgcn_mfma_f32_32x32x16_bf16(pa1, (bf16x8){l1[0], l1[1], l1[2], l1[3], h1[0], h1[1], h1[2], h1[3]}, o[d0], 0, 0, 0); \
        o[d0] = __builtin_amdgcn_mfma_f32_32x32x16_bf16(pa2, (bf16x8){l2[0], l2[1], l2[2], l2[3], h2[0], h2[1], h2[2], h2[3]}, o[d0], 0, 0, 0); \
        o[d0] = __builtin_amdgcn_mfma_f32_32x32x16_bf16(pa3, (bf16x8){l3[0], l3[1], l3[2], l3[3], h3[0], h3[1], h3[2], h3[3]}, o[d0], 0, 0, 0); } while (0)
    PV_D0(0); PV_D0(1); PV_D0(2); PV_D0(3);
#undef PV_D0
#undef TRRD
}
DI void pack_p(const f32x16& p0, const f32x16& p1, bf16x8& pa0, bf16x8& pa1, bf16x8& pa2, bf16x8& pa3) {
#define PK4(P, B_, OUT) do { unsigned a0 = cvtpk(P[B_+0], P[B_+1]), a1 = cvtpk(P[B_+2], P[B_+3]); \
        unsigned b0 = cvtpk(P[B_+4], P[B_+5]), b1 = cvtpk(P[B_+6], P[B_+7]); \
        auto r0 = __builtin_amdgcn_permlane32_swap(a0, b0, false, false); auto r1 = __builtin_amdgcn_permlane32_swap(a1, b1, false, false); \
        u32x4 w = {r0[0], r1[0], r0[1], r1[1]}; OUT = __builtin_bit_cast(bf16x8, w); } while (0)
    PK4(p0, 0, pa0); PK4(p0, 8, pa1); PK4(p1, 0, pa2); PK4(p1, 8, pa3);
#undef PK4
}
DI float half_max(float v) { auto rr = __builtin_amdgcn_permlane32_swap(__float_as_uint(v), __float_as_uint(v), false, false); return fmaxf(__uint_as_float(rr[0]), __uint_as_float(rr[1])); }
DI float half_sum(float v) { auto rr = __builtin_amdgcn_permlane32_swap(__float_as_uint(v), __float_as_uint(v), false, false); return __uint_as_float(rr[0]) + __uint_as_float(rr[1]); }

#define DPP_U32(x, ctrl) ((unsigned)__builtin_amdgcn_update_dpp((int)(x), (int)(x), (ctrl), 0xF, 0xF, false))
DI unsigned wave_max_u32(unsigned x) {
    unsigned y;
    y = DPP_U32(x, 0xB1); x = x > y ? x : y;
    y = DPP_U32(x, 0x4E); x = x > y ? x : y;
    y = DPP_U32(x, 0x141); x = x > y ? x : y;
    y = DPP_U32(x, 0x140); x = x > y ? x : y;
    { auto r = __builtin_amdgcn_permlane16_swap(x, x, false, false); x = r[0] > r[1] ? r[0] : r[1]; }
    { auto r = __builtin_amdgcn_permlane32_swap(x, x, false, false); x = r[0] > r[1] ? r[0] : r[1]; }
    return x;
}
DI float quad_sum(float v) {
    v += __uint_as_float(DPP_U32(__float_as_uint(v), 0xB1));
    v += __uint_as_float(DPP_U32(__float_as_uint(v), 0x4E));
    return v;
}
DI float partner32(float v, int hi) { auto rr = __builtin_amdgcn_permlane32_swap(__float_as_uint(v), __float_as_uint(v), false, false); return __uint_as_float(hi ? rr[0] : rr[1]); }

enum { M_CMP1 = 0, M_CMP2 = 1, M_SLC = 2, M_WIN = 3 };

struct NsaCtx {
    LAS char* lds; int tid, wid, lane, r32, hi, sr, sc, vb0;
    int b, g, t0, t;
    float slope2;
    const bf16_t* proj; const bf16_t* kcmp; const bf16_t* vcmp; const float* gates;
    unsigned sel0, sel1, sel2, sel3;
};

DI void dma_src_k(int P, int& row, int& col) { row = P >> 8; col = ((((P & 255) >> 4) ^ (row & 7)) << 3); }
DI void dma_src_v(int P, int& row, int& col) { const int st = P >> 9, wi = (P & 511) >> 1, kk = (st >> 2) * 8 + (wi >> 5); row = (kk & ~0xC) | ((kk & 4) << 1) | ((kk & 8) >> 1); col = (st & 3) * 32 + (wi & 31); }
struct DmaOff { unsigned ko[2], vo[2]; };
DI void dma_init(DmaOff& D, int wid, int lane, int pitch) {
#pragma unroll
    for (int i = 0; i < 2; ++i) { int r_, c_; dma_src_k(i * 8192 + wid * 1024 + lane * 16, r_, c_); D.ko[i] = (unsigned)(r_ * pitch + c_); dma_src_v(i * 8192 + wid * 1024 + lane * 16, r_, c_); D.vo[i] = (unsigned)(r_ * pitch + c_); }
}
template <bool NEEDV> DI void dma_tile(LAS char* lds, const DmaOff& D, const bf16_t* kt, const bf16_t* vt, int buf, int wid) {
#pragma unroll
    for (int i = 0; i < 2; ++i) {
        __builtin_amdgcn_global_load_lds((const unsigned*)(kt + D.ko[i]), (LAS unsigned*)(lds + L_K + buf * SHM + i * 8192 + wid * 1024), 16, 0, 0);
        if (NEEDV) __builtin_amdgcn_global_load_lds((const unsigned*)(vt + D.vo[i]), (LAS unsigned*)(lds + L_V + buf * SHM + i * 8192 + wid * 1024), 16, 0, 0); }
}
template <int NLD> DI void dma_wait(bool newest_in_flight) {
    if (newest_in_flight) { if (NLD == 4) asm volatile("s_waitcnt vmcnt(4)" ::: "memory"); else asm volatile("s_waitcnt vmcnt(2)" ::: "memory"); }
    else asm volatile("s_waitcnt vmcnt(0)" ::: "memory");
}

template <int MODE, bool PRE = false>
DI void nsa_pass(const NsaCtx& c, const bf16x8* qr, f32x16* o, float& m_reg, float& l_reg, float inv_l, int nt_or_jlo, int jhi, const unsigned* uni) {
    constexpr bool NEEDV = (MODE != M_CMP1), CMP = (MODE == M_CMP1 || MODE == M_CMP2); constexpr int NLD = NEEDV ? 4 : 2;
    const size_t rowbase = (size_t)c.b * T_;
    const bf16_t* Kb; const bf16_t* Vb; const int pitch = CMP ? 128 : LDP0;
    if (CMP) { Kb = c.kcmp + (size_t)(c.b * 4 + c.g) * 512 * 128; Vb = c.vcmp + (size_t)(c.b * 4 + c.g) * 512 * 128; }
    else if (MODE == M_SLC) { Kb = c.proj + rowbase * LDP0 + C_KS + c.g * 128; Vb = c.proj + rowbase * LDP0 + C_VS + c.g * 128; }
    else { Kb = c.proj + rowbase * LDP0 + C_KW + c.g * 128; Vb = c.proj + rowbase * LDP0 + C_VW + c.g * 128; }
    LAS float* ws = (LAS float*)(c.lds + L_WS) + c.wid * 128;
    LAS float* imp = (LAS float*)(c.lds + L_STG + c.wid * STG_W);
    DmaOff D; dma_init(D, c.wid, c.lane, pitch);
    const float s32 = 32.f * c.slope2, s64 = 64.f * c.slope2, hb = 4.f * (float)c.hi * c.slope2;
    const int twmin = c.t0 + c.wid * 8, twmax = twmin + 7, jd = c.t0 >> 6;
    unsigned u0 = 0, u1 = 0, u2 = 0, u3 = 0; int jw = jhi;
    if (MODE == M_SLC) { u0 = uni[0]; u1 = uni[1]; u2 = uni[2]; u3 = uni[3]; }
    unsigned sl0 = c.sel0, sl1 = c.sel1, sl2 = c.sel2, sl3 = c.sel3; asm volatile("" : "+v"(sl0), "+v"(sl1), "+v"(sl2), "+v"(sl3));
#define NEXT_T(jj, hv) do { if (MODE == M_SLC) { \
            if (u3) { const int b_ = 31 - __builtin_clz(u3); jj = 96 + b_; u3 &= ~(1u << b_); hv = true; } else if (u2) { const int b_ = 31 - __builtin_clz(u2); jj = 64 + b_; u2 &= ~(1u << b_); hv = true; } \
            else if (u1) { const int b_ = 31 - __builtin_clz(u1); jj = 32 + b_; u1 &= ~(1u << b_); hv = true; } else if (u0) { const int b_ = 31 - __builtin_clz(u0); jj = b_; u0 &= ~(1u << b_); hv = true; } else hv = false; } \
        else if (CMP) { jj = jw; hv = jw < nt_or_jlo; ++jw; } \
        else { jj = jw; hv = jw >= nt_or_jlo; --jw; } } while (0)
#define SELBIT(jj) ((((jj) < 32 ? sl0 : (jj) < 64 ? sl1 : (jj) < 96 ? sl2 : sl3) >> ((jj) & 31)) & 1u)
    int j0 = 0, j1 = 0; bool h0, h1;
    NEXT_T(j0, h0); NEXT_T(j1, h1);
    if (!PRE) {
        __syncthreads();
        if (h0) dma_tile<NEEDV>(c.lds, D, Kb + (size_t)j0 * 64 * pitch, Vb + (size_t)j0 * 64 * pitch, 0, c.wid);
    }
    asm volatile("s_waitcnt vmcnt(0)" ::: "memory");
    __syncthreads();
    float prev_cy = 0.f;
    int cur = 0, jprev = j0;
    while (h0) {
        if (h1) dma_tile<NEEDV>(c.lds, D, Kb + (size_t)j1 * 64 * pitch, Vb + (size_t)j1 * 64 * pitch, cur ^ 1, c.wid);
        const int j = j0;
        bool act;
        if (CMP) act = (j * 1024 + 31) <= twmax;
        else if (MODE == M_SLC) act = __any(SELBIT(j) != 0u);
        else act = true;
        if (!CMP && act && __all(inv_l + s64 - (m_reg + s64 * (float)(jprev - j)) < -152.f)) act = false;
        if (act) {
            f32x16 p0, p1;
            if (CMP) qkt<false>(p0, p1, c.lds + L_K + cur * SHM, c.r32, c.hi, qr); else qkt<true>(p0, p1, c.lds + L_K + cur * SHM, c.r32, c.hi, qr, c.slope2);
            const float NEG = -__builtin_inff();
            if (CMP) {
                const int dq = c.t - 31 - 1024 * j - 64 * c.hi; const float base = -c.slope2 * (float)dq, s16 = c.slope2 * 16.f;
#pragma unroll
                for (int r = 0; r < 16; ++r) { const int cc = (r & 3) + 8 * (r >> 2);
                    p0[r] = (dq - 16 * cc >= 0) ? fmaf(s16, (float)cc, p0[r] + base) : NEG;
                    p1[r] = (dq - 16 * cc - 512 >= 0) ? fmaf(s16, (float)(cc + 32), p1[r] + base) : NEG; }
            } else {
                m_reg += s64 * (float)(jprev - j); jprev = j;
                if (MODE == M_WIN) { if (!(64 * j + 63 <= twmin && twmax - 64 * j < 512)) { const int dq = c.t - 64 * j - 4 * c.hi;
#pragma unroll
                        for (int r = 0; r < 16; ++r) { const int cc = (r & 3) + 8 * (r >> 2);
                            if ((unsigned)(dq - cc) >= 512u) p0[r] = NEG; if ((unsigned)(dq - cc - 32) >= 512u) p1[r] = NEG; } } }
                else { const unsigned sb = SELBIT(j);
                    if (j == jd) { const int dq = c.t - 64 * j - 4 * c.hi;
#pragma unroll
                        for (int r = 0; r < 16; ++r) { const int cc = (r & 3) + 8 * (r >> 2);
                            if (dq - cc < 0) p0[r] = NEG; if (dq - cc - 32 < 0) p1[r] = NEG; } }
                    if (!__all(sb != 0u)) { if (!sb) {
#pragma unroll
                            for (int r = 0; r < 16; ++r) { p0[r] = NEG; p1[r] = NEG; } } } }
            }
            if (MODE == M_CMP2) {
#pragma unroll
                for (int r = 0; r < 16; ++r) { p0[r] = __builtin_amdgcn_exp2f(p0[r] - m_reg) * inv_l; p1[r] = __builtin_amdgcn_exp2f(p1[r] - m_reg) * inv_l; }
                float w[8], cy[8];
#pragma unroll
                for (int s = 0; s < 8; ++s) { const int gi = s & 3;
                    const float x0 = (s >> 2) ? p1[4 * gi] : p0[4 * gi], x1 = (s >> 2) ? p1[4 * gi + 1] : p0[4 * gi + 1], x2 = (s >> 2) ? p1[4 * gi + 2] : p0[4 * gi + 2], x3 = (s >> 2) ? p1[4 * gi + 3] : p0[4 * gi + 3];
                    cy[s] = quad_sum(0.5f * x3); w[s] = quad_sum((x0 + x1) + x2) + cy[s]; }
                float pc[8];
#pragma unroll
                for (int s = 0; s < 8; ++s) pc[s] = partner32(cy[s], c.hi);
#pragma unroll
                for (int s = 0; s < 8; ++s) w[s] += c.hi ? pc[s] : (s == 0 ? prev_cy : pc[s - 1]);
                prev_cy = pc[7];
                if ((c.r32 & 3) == 0) {
#pragma unroll
                    for (int s = 0; s < 8; ++s) imp[(c.r32 >> 2) * 128 + j * 16 + 2 * s + c.hi] = w[s]; }
                bf16x8 pa0, pa1, pa2, pa3; pack_p(p0, p1, pa0, pa1, pa2, pa3);
                pv_tile(o, c.vb0 + cur * SHM, pa0, pa1, pa2, pa3);
            } else {
                float mx0 = fmaxf(fmaxf(p0[0], p0[1]), p0[2]), mx1 = fmaxf(fmaxf(p1[0], p1[1]), p1[2]);
#pragma unroll
                for (int r = 3; r < 15; r += 2) { mx0 = fmaxf(fmaxf(mx0, p0[r]), p0[r + 1]); mx1 = fmaxf(fmaxf(mx1, p1[r]), p1[r + 1]); }
                mx0 = fmaxf(mx0, p0[15]); mx1 = fmaxf(mx1, p1[15]);
                const float pmax = half_max(CMP ? fmaxf(mx0, mx1) : fmaxf(mx0, mx1 + s32) + hb);
                const float mn = fmaxf(m_reg, pmax), alpha = __builtin_amdgcn_exp2f(m_reg - mn); m_reg = mn;
                const float off0 = CMP ? -mn : hb - mn, off1 = CMP ? -mn : off0 + s32;
                f32x2 ps2 = {0.f, 0.f};
#pragma unroll
                for (int r = 0; r < 16; r += 2) { f32x2 a = (f32x2){p0[r], p0[r + 1]} + off0, bq = (f32x2){p1[r], p1[r + 1]} + off1;
                    a.x = __builtin_amdgcn_exp2f(a.x); a.y = __builtin_amdgcn_exp2f(a.y); bq.x = __builtin_amdgcn_exp2f(bq.x); bq.y = __builtin_amdgcn_exp2f(bq.y);
                    p0[r] = a.x; p0[r + 1] = a.y; p1[r] = bq.x; p1[r + 1] = bq.y; ps2 += a; ps2 += bq; }
                float ps = half_sum(ps2.x + ps2.y);
                l_reg = l_reg * alpha + ps;
                if (MODE != M_CMP1) {
                    if (__any(alpha < 1.f)) { if (c.hi == 0) ws[32 + c.r32] = alpha; asm volatile("s_waitcnt lgkmcnt(0)" ::: "memory");
#pragma unroll
                        for (int r = 0; r < 16; ++r) { const float a = ws[32 + crow(r, c.hi)];
#pragma unroll
                            for (int d = 0; d < 4; ++d) o[d][r] *= a; } }
                    bf16x8 pa0, pa1, pa2, pa3; pack_p(p0, p1, pa0, pa1, pa2, pa3);
                    pv_tile(o, c.vb0 + cur * SHM, pa0, pa1, pa2, pa3);
                }
            }
        }
        asm volatile("s_waitcnt vmcnt(0)" ::: "memory");
        __syncthreads();
        j0 = j1; h0 = h1; NEXT_T(j1, h1); cur ^= 1;
    }
#undef NEXT_T
#undef SELBIT
}

template <int MODE>
DI void nsa_issue(const NsaCtx& c, int nt_or_jlo, int jhi, const unsigned* uni) {
    constexpr bool NEEDV = (MODE != M_CMP1), CMP = (MODE == M_CMP1 || MODE == M_CMP2);
    const size_t rowbase = (size_t)c.b * T_;
    const bf16_t* Kb; const bf16_t* Vb; const int pitch = CMP ? 128 : LDP0;
    if (CMP) { Kb = c.kcmp + (size_t)(c.b * 4 + c.g) * 512 * 128; Vb = c.vcmp + (size_t)(c.b * 4 + c.g) * 512 * 128; }
    else if (MODE == M_SLC) { Kb = c.proj + rowbase * LDP0 + C_KS + c.g * 128; Vb = c.proj + rowbase * LDP0 + C_VS + c.g * 128; }
    else { Kb = c.proj + rowbase * LDP0 + C_KW + c.g * 128; Vb = c.proj + rowbase * LDP0 + C_VW + c.g * 128; }
    DmaOff D; dma_init(D, c.wid, c.lane, pitch);
    int j0 = 0; bool h0 = false;
    if (MODE == M_SLC) {
#pragma unroll
        for (int w = 3; w >= 0; --w) { if (!h0 && uni[w]) { j0 = 32 * w + 31 - __builtin_clz(uni[w]); h0 = true; } } }
    else if (CMP) { j0 = jhi; h0 = jhi < nt_or_jlo; }
    else { j0 = jhi; h0 = jhi >= nt_or_jlo; }
    __syncthreads();
    if (h0) dma_tile<NEEDV>(c.lds, D, Kb + (size_t)j0 * 64 * pitch, Vb + (size_t)j0 * 64 * pitch, 0, c.wid);
}

template <bool ADD> DI void stage_put(const NsaCtx& c, const f32x16* o, float rowscale) {
    LAS float* ws = (LAS float*)(c.lds + L_WS) + c.wid * 128;
    LAS char* st = c.lds + L_STG + c.wid * STG_W;
    if (c.hi == 0) ws[c.r32] = rowscale;
    asm volatile("s_waitcnt lgkmcnt(0)" ::: "memory");
    const bool ev = (c.r32 & 1) == 0;
#pragma unroll
    for (int rg = 0; rg < 4; ++rg) {
        unsigned prev[16]; float s[4];
#pragma unroll
        for (int rr = 0; rr < 4; ++rr) { const int row = crow(rg * 4 + rr, c.hi); s[rr] = ws[row];
#pragma unroll
            for (int d0 = 0; d0 < 4; ++d0) prev[rr * 4 + d0] = (ADD && ev) ? *(const LAS unsigned*)(st + row * 272 + (d0 * 32 + c.r32) * 2) : 0u; }
        asm volatile("s_waitcnt lgkmcnt(0)" ::: "memory");
#pragma unroll
        for (int rr = 0; rr < 4; ++rr) { const int r = rg * 4 + rr, row = crow(r, c.hi);
#pragma unroll
            for (int d0 = 0; d0 < 4; ++d0) { float v = o[d0][r] * s[rr]; float vn = __uint_as_float(DPP_U32(__float_as_uint(v), 0xB1));
                if (ADD) { v += bflo(prev[rr * 4 + d0]); vn += bfhi(prev[rr * 4 + d0]); }
                if (ev) *(LAS unsigned*)(st + row * 272 + (d0 * 32 + c.r32) * 2) = cvtpk(v, vn); } }
    }
    asm volatile("s_waitcnt lgkmcnt(0)" ::: "memory");
}
DI void stage_flush(const NsaCtx& c, bf16_t* att) {
    const LAS char* st = c.lds + L_STG + c.wid * STG_W;
#pragma unroll
    for (int i = 0; i < 8; ++i) { const int ch = i * 64 + c.lane, row = ch >> 4, part = ch & 15;
        const u32x4 v = *(const LAS u32x4*)(st + row * 272 + part * 16);
        *(u32x4*)(att + (size_t)(c.b * T_ + c.t0 + c.wid * 8 + (row >> 2)) * DM + (c.g * 4 + (row & 3)) * 128 + part * 8) = v; }
}
DI void nsa_ctx(NsaCtx& c, LAS char* lds, int item, const bf16_t* proj, const bf16_t* kcmp, const bf16_t* vcmp, const float* gates) {
    c.gates = gates;
    c.lds = lds; c.tid = threadIdx.x; asm volatile("" : "+v"(c.tid));
    c.wid = __builtin_amdgcn_readfirstlane(c.tid >> 6); c.lane = c.tid & 63; c.r32 = c.lane & 31; c.hi = c.lane >> 5;
    c.sr = c.tid >> 4; c.sc = (c.tid & 15) * 8; c.vb0 = (int)(unsigned)(uintptr_t)(lds + L_V) + v_rd_base(c.lane);
    c.b = item >> 9; c.g = (item >> 7) & 3; c.t0 = (item & 127) * 64;
    c.proj = proj; c.kcmp = kcmp; c.vcmp = vcmp;
    const int q8 = c.r32 >> 2, hr = c.r32 & 3, head = c.g * 4 + hr; c.t = c.t0 + c.wid * 8 + q8;
    c.slope2 = __builtin_amdgcn_exp2f(-0.5f * (float)(head + 1)) * LOG2E;
    c.sel0 = c.sel1 = c.sel2 = c.sel3 = 0u;
}
DI void nsa_loadq(const NsaCtx& c, const float* qk_gain, bf16x8* qr, float* gate) {
    const int head = c.g * 4 + (c.r32 & 3);
    const size_t tokrow = (size_t)(c.b * T_ + c.t) * LDP0;
    float qf[64]; float ss = 0.f;
    const bf16_t* qp = c.proj + tokrow + C_Q + head * 128 + c.hi * 8;
#pragma unroll
    for (int d0 = 0; d0 < 8; ++d0) { const u32x4 raw = *(const u32x4*)(qp + d0 * 16);
#pragma unroll
        for (int e = 0; e < 4; ++e) { const float a = bflo(raw[e]), bq = bfhi(raw[e]); qf[d0 * 8 + 2 * e] = a; qf[d0 * 8 + 2 * e + 1] = bq; ss += a * a + bq * bq; } }
    ss = half_sum(ss);
    const float rs = __builtin_amdgcn_rsqf(ss * (1.0f / 128.0f) + 1e-6f) * (QSCALE * LOG2E);
#pragma unroll
    for (int d0 = 0; d0 < 8; ++d0) { const float* gp = qk_gain + d0 * 16 + c.hi * 8; const f32x4 g0 = *(const f32x4*)gp, g1 = *(const f32x4*)(gp + 4);
        f32x4 a = {qf[d0 * 8] * rs * g0[0], qf[d0 * 8 + 1] * rs * g0[1], qf[d0 * 8 + 2] * rs * g0[2], qf[d0 * 8 + 3] * rs * g0[3]};
        f32x4 bq = {qf[d0 * 8 + 4] * rs * g1[0], qf[d0 * 8 + 5] * rs * g1[1], qf[d0 * 8 + 6] * rs * g1[2], qf[d0 * 8 + 7] * rs * g1[3]};
        qr[d0] = pack8(a, bq); }
#pragma unroll
    for (int br = 0; br < 3; ++br) gate[br] = c.gates[(size_t)(c.b * T_ + c.t) * 48 + br * 16 + head];
}
DI void nsa_item(LAS char* lds, int item, const bf16_t* proj, const bf16_t* kcmp, const bf16_t* vcmp, const float* gates, const float* qk_gain, bf16_t* att) {
    NsaCtx c; bf16x8 qr[8]; float gate[3];
    nsa_ctx(c, lds, item, proj, kcmp, vcmp, gates);
    int nkt = ((c.t0 >> 4) + 2) / 64 + 1; if (nkt > 8) nkt = 8;
    float gm[4];
#pragma unroll
    for (int i = 0; i < 4; ++i) { const float a_ = fmaxf(fabsf(qk_gain[i * 128 + c.lane]), fabsf(qk_gain[i * 128 + 64 + c.lane])); gm[i] = __uint_as_float(wave_max_u32(__float_as_uint(a_))); }
    const float bq = 128.f * QSCALE * LOG2E * 1.02f * gm[0], B_c = bq * gm[1], B_s = bq * gm[2], B_w = bq * gm[3];
    int jfirst = 0;
    { const float s2min = __builtin_amdgcn_exp2f(-(float)(2 * c.g + 2)) * LOG2E, D = (2.f * B_c + 152.f) / s2min + 15.f, x = (float)c.t0 - 1054.f - D;
      if (x > 0.f) jfirst = (int)__builtin_ceilf(x * (1.0f / 1024.0f)); if (jfirst > nkt - 1) jfirst = nkt - 1; }
    jfirst = __builtin_amdgcn_readfirstlane(jfirst);
    nsa_issue<M_CMP1>(c, nkt, jfirst, nullptr);
    nsa_loadq(c, qk_gain, qr, gate);
    LAS float* imp = (LAS float*)(lds + L_STG + c.wid * STG_W);
#pragma unroll
    for (int i = 0; i < 16; ++i) imp[i * 64 + c.lane] = 0.f;
    LAS unsigned* selm = (LAS unsigned*)(lds + L_SEL);
    LAS unsigned* uni = (LAS unsigned*)(lds + L_UNI);
    if (c.tid < 4) uni[c.tid] = 0u;
    f32x16 o[4] = {};
    float m_c = -1e30f, l_c = 0.f;
    nsa_pass<M_CMP1, true>(c, qr, o, m_c, l_c, 0.f, nkt, jfirst, nullptr);
    const float inv_l = l_c > 0.f ? __builtin_amdgcn_rcpf(l_c) : 0.f;
    nsa_pass<M_CMP2>(c, qr, o, m_c, l_c, inv_l, nkt, jfirst, nullptr);
    {
        unsigned k0[8], k1[8];
        const int j0 = c.lane, j1 = c.lane + 64;
#pragma unroll
        for (int q = 0; q < 8; ++q) { const int jd = (c.t0 + c.wid * 8 + q) >> 6;
            const float v0 = imp[q * 128 + c.lane], v1 = imp[q * 128 + 64 + c.lane];
            k0[q] = j0 > jd ? 0u : (((j0 == 0 || j0 == jd) ? 0x80000000u : (((__float_as_uint(v0) >> 7) + 1u) << 7)) | (unsigned)(127 - j0));
            k1[q] = j1 > jd ? 0u : (((j1 == jd) ? 0x80000000u : (((__float_as_uint(v1) >> 7) + 1u) << 7)) | (unsigned)(127 - j1)); }
        asm volatile("s_waitcnt lgkmcnt(0)" ::: "memory");
        stage_put<false>(c, o, gate[0]);
        unsigned T[8];
#pragma unroll
        for (int q = 0; q < 8; ++q) T[q] = 0u;
        for (int bit = 31; bit >= 0; --bit) {
#pragma unroll
            for (int q = 0; q < 8; ++q) { const unsigned cand = T[q] | (1u << bit);
                const int cnt = __builtin_popcountll(__ballot(k0[q] >= cand)) + __builtin_popcountll(__ballot(k1[q] >= cand));
                T[q] = cnt >= 16 ? cand : T[q]; }
        }
#pragma unroll
        for (int q = 0; q < 8; ++q) { const unsigned th = T[q] ? T[q] : 1u;
            const unsigned long long lo = __ballot(k0[q] >= th), hi64 = __ballot(k1[q] >= th);
            if (c.lane == 0) { const int qi = (c.wid * 8 + q) * 4;
                selm[qi] = (unsigned)lo; selm[qi + 1] = (unsigned)(lo >> 32); selm[qi + 2] = (unsigned)hi64; selm[qi + 3] = (unsigned)(hi64 >> 32);
                __hip_atomic_fetch_or(uni + 0, (unsigned)lo, __ATOMIC_RELAXED, __HIP_MEMORY_SCOPE_WORKGROUP); __hip_atomic_fetch_or(uni + 1, (unsigned)(lo >> 32), __ATOMIC_RELAXED, __HIP_MEMORY_SCOPE_WORKGROUP);
                __hip_atomic_fetch_or(uni + 2, (unsigned)hi64, __ATOMIC_RELAXED, __HIP_MEMORY_SCOPE_WORKGROUP); __hip_atomic_fetch_or(uni + 3, (unsigned)(hi64 >> 32), __ATOMIC_RELAXED, __HIP_MEMORY_SCOPE_WORKGROUP); }
        }
    }
    __syncthreads();
    unsigned un[4];
    {
#pragma unroll
        for (int i = 0; i < 4; ++i) un[i] = (unsigned)__builtin_amdgcn_readfirstlane((int)uni[i]);
        const int qi = (c.wid * 8 + (c.r32 >> 2)) * 4; c.sel0 = selm[qi]; c.sel1 = selm[qi + 1]; c.sel2 = selm[qi + 2]; c.sel3 = selm[qi + 3];
    }
#pragma unroll
    for (int d = 0; d < 4; ++d) o[d] = f32x16{};
    float m_s = -1e30f, l_s = 0.f;
    nsa_pass<M_SLC>(c, qr, o, m_s, l_s, B_s, 0, 0, un);
    stage_put<true>(c, o, gate[1] * (l_s > 0.f ? __builtin_amdgcn_rcpf(l_s) : 0.f));
#pragma unroll
    for (int d = 0; d < 4; ++d) o[d] = f32x16{};
    float m_w = -1e30f, l_w = 0.f;
    const int jhi = c.t0 >> 6, jlo = jhi - 8 > 0 ? jhi - 8 : 0;
    nsa_pass<M_WIN>(c, qr, o, m_w, l_w, B_w, jlo, jhi, nullptr);
    stage_put<true>(c, o, gate[2] * (l_w > 0.f ? __builtin_amdgcn_rcpf(l_w) : 0.f));
    stage_flush(c, att);
    __syncthreads();
}
}

namespace at {
DI void sb_item(LAS char* lds, int item, const bf16_t* proj, bf16_t* att) {
    constexpr int SB_K = 0, SB_V = 4 * SHM;
    int tid = threadIdx.x; asm volatile("" : "+v"(tid));
    const int wid = __builtin_amdgcn_readfirstlane(tid >> 6), lane = tid & 63, r32 = lane & 31, hi = lane >> 5, half = wid >> 2, wq = wid & 3;
    const int b = item >> 9, hp = (item >> 6) & 7, qb = item & 63, h = hp * 2 + half, q0 = qb * 128, t = q0 + wq * 32 + r32;
    const int vb0 = (int)(unsigned)(uintptr_t)(lds + SB_V + half * 2 * SHM) + v_rd_base(lane);
    LAS unsigned* flg = (LAS unsigned*)(lds + L_FLAG);
    const bf16_t* Kb = proj + (size_t)b * T_ * LDP1 + DM + h * 128; const bf16_t* Vb = proj + (size_t)b * T_ * LDP1 + 2 * DM + h * 128;
    unsigned ko[4], vo[4];
#pragma unroll
    for (int i = 0; i < 4; ++i) { int r_, c_; dma_src_k(i * 4096 + wq * 1024 + lane * 16, r_, c_); ko[i] = (unsigned)(r_ * LDP1 + c_); dma_src_v(i * 4096 + wq * 1024 + lane * 16, r_, c_); vo[i] = (unsigned)(r_ * LDP1 + c_); }
#define SB_DMA(jj, bufi) do { const bf16_t* kt_ = Kb + (size_t)(jj) * 64 * LDP1; const bf16_t* vt_ = Vb + (size_t)(jj) * 64 * LDP1; \
        _Pragma("unroll") for (int i_ = 0; i_ < 4; ++i_) { \
            __builtin_amdgcn_global_load_lds((const unsigned*)(kt_ + ko[i_]), (LAS unsigned*)(lds + SB_K + (half * 2 + (bufi)) * SHM + i_ * 4096 + wq * 1024), 16, 0, 0); \
            __builtin_amdgcn_global_load_lds((const unsigned*)(vt_ + vo[i_]), (LAS unsigned*)(lds + SB_V + (half * 2 + (bufi)) * SHM + i_ * 4096 + wq * 1024), 16, 0, 0); } } while (0)
    int jt = qb * 2 + 1, buf = 0;
    __syncthreads();
    if (tid < 16) flg[tid] = 0u;
    SB_DMA(jt, 0);
    bf16x8 qr[8];
    {
        const bf16_t* qp = proj + (size_t)(b * T_ + t) * LDP1 + h * 128 + hi * 8; const float sc2 = QSCALE * LOG2E;
#pragma unroll
        for (int d0 = 0; d0 < 8; ++d0) { const u32x4 raw = *(const u32x4*)(qp + d0 * 16);
            f32x4 a = {bflo(raw[0]) * sc2, bfhi(raw[0]) * sc2, bflo(raw[1]) * sc2, bfhi(raw[1]) * sc2}, bq = {bflo(raw[2]) * sc2, bfhi(raw[2]) * sc2, bflo(raw[3]) * sc2, bfhi(raw[3]) * sc2};
            qr[d0] = pack8(a, bq); }
    }
    f32x16 o[4] = {}; float carry = 0.f; bool wdone = false;
    const int twmax = q0 + wq * 32 + 31;
    asm volatile("s_waitcnt vmcnt(0)" ::: "memory");
    __syncthreads();
    for (int itn = 0;; ++itn) {
        if (itn > 0) { unsigned nd = 0;
#pragma unroll
            for (int i = 0; i < 8; ++i) nd += flg[((itn - 1) & 1) * 8 + i];
            if (__builtin_amdgcn_readfirstlane((int)nd) == 8) break; }
        const int jn = jt - 1;
        if (jn >= 0) SB_DMA(jn, buf ^ 1);
        if (!wdone && 64 * jt < twmax) {
            f32x16 p0, p1;
            qkt(p0, p1, lds + SB_K + (half * 2 + buf) * SHM, r32, hi, qr);
            const int dq = t - 64 * jt - 4 * hi;
            f32x16 l0, l1;
            const float NEG = -__builtin_inff();
#pragma unroll
            for (int r = 0; r < 16; ++r) { const int cc = (r & 3) + 8 * (r >> 2);
                { const float z = p0[r]; const float sp = fmaxf(z, 0.f) + __builtin_amdgcn_logf(1.0f + __builtin_amdgcn_exp2f(-fabsf(z))); const bool v = (dq - cc) > 0; l0[r] = v ? -sp : 0.f; p0[r] = v ? z - sp : NEG; }
                { const float z = p1[r]; const float sp = fmaxf(z, 0.f) + __builtin_amdgcn_logf(1.0f + __builtin_amdgcn_exp2f(-fabsf(z))); const bool v = (dq - cc - 32) > 0; l1[r] = v ? -sp : 0.f; p1[r] = v ? z - sp : NEG; } }
            float own[8], par[8], aft[8];
#pragma unroll
            for (int gi = 0; gi < 4; ++gi) { own[gi] = (l0[4 * gi] + l0[4 * gi + 1]) + (l0[4 * gi + 2] + l0[4 * gi + 3]); own[4 + gi] = (l1[4 * gi] + l1[4 * gi + 1]) + (l1[4 * gi + 2] + l1[4 * gi + 3]); }
#pragma unroll
            for (int pi = 0; pi < 8; ++pi) par[pi] = partner32(own[pi], hi);
            float run = 0.f;
#pragma unroll
            for (int pi = 7; pi >= 0; --pi) { aft[pi] = run + (hi == 0 ? par[pi] : 0.f); run += own[pi] + par[pi]; }
#pragma unroll
            for (int gi = 0; gi < 4; ++gi) {
                { float a = carry + aft[gi]; p0[4 * gi + 3] = __builtin_amdgcn_exp2f(p0[4 * gi + 3] + a); a += l0[4 * gi + 3]; p0[4 * gi + 2] = __builtin_amdgcn_exp2f(p0[4 * gi + 2] + a); a += l0[4 * gi + 2];
                  p0[4 * gi + 1] = __builtin_amdgcn_exp2f(p0[4 * gi + 1] + a); a += l0[4 * gi + 1]; p0[4 * gi] = __builtin_amdgcn_exp2f(p0[4 * gi] + a); }
                { float a = carry + aft[4 + gi]; p1[4 * gi + 3] = __builtin_amdgcn_exp2f(p1[4 * gi + 3] + a); a += l1[4 * gi + 3]; p1[4 * gi + 2] = __builtin_amdgcn_exp2f(p1[4 * gi + 2] + a); a += l1[4 * gi + 2];
                  p1[4 * gi + 1] = __builtin_amdgcn_exp2f(p1[4 * gi + 1] + a); a += l1[4 * gi + 1]; p1[4 * gi] = __builtin_amdgcn_exp2f(p1[4 * gi] + a); } }
            carry += run;
            bf16x8 pa0, pa1, pa2, pa3; pack_p(p0, p1, pa0, pa1, pa2, pa3);
            pv_tile(o, vb0 + buf * SHM, pa0, pa1, pa2, pa3);
            if (__all(carry < -160.f)) wdone = true;
        }
        if (wdone && lane == 0) flg[(itn & 1) * 8 + wid] = 1u;
        asm volatile("s_waitcnt vmcnt(0)" ::: "memory");
        __syncthreads();
        if (jn < 0) break;
        jt = jn; buf ^= 1;
    }
#undef SB_DMA
    {
        LAS char* st = lds + wid * STG_W;
#pragma unroll
        for (int r = 0; r < 16; ++r) { const int row = crow(r, hi);
#pragma unroll
            for (int d0 = 0; d0 < 4; ++d0) { const float v = o[d0][r]; const float vn = __shfl_xor(v, 1);
                if ((r32 & 1) == 0) *(LAS unsigned*)(st + row * 272 + (d0 * 32 + r32) * 2) = cvtpk(v, vn); } }
        asm volatile("s_waitcnt lgkmcnt(0)" ::: "memory");
#pragma unroll
        for (int i = 0; i < 8; ++i) { const int ch = i * 64 + lane, row = ch >> 4, part = ch & 15;
            const u32x4 v = *(const LAS u32x4*)(st + row * 272 + part * 16);
            *(u32x2*)((unsigned char*)att + (size_t)(b * T_ + q0 + wq * 32 + row) * DM + h * 128 + part * 8) = cvt8_fp8(v, 16.f); }
    }
}
}

struct TcJob { const float* src; bf16_t* dst; int ld, nvalid, K, k0, n0; float f8; };
DI void tconv_load(const TcJob& J, f32x4 (&v)[8]) {
    int tid = threadIdx.x; asm volatile("" : "+v"(tid));
#pragma unroll
    for (int i = 0; i < 8; ++i) { const int idx = tid + 512 * i, k = idx >> 5, n4 = idx & 31;
        v[i] = (f32x4){0.f, 0.f, 0.f, 0.f};
        if (J.n0 + 4 * n4 < J.nvalid) v[i] = __builtin_nontemporal_load((const f32x4*)(J.src + (size_t)(J.k0 + k) * J.ld + J.n0 + 4 * n4)); }
}
DI void tconv_lds(const f32x4 (&v)[8], LAS unsigned char* lds) {
    int tid = threadIdx.x; asm volatile("" : "+v"(tid)); constexpr int RS = 264;
#pragma unroll
    for (int i = 0; i < 8; ++i) { const int idx = tid + 512 * i, k = idx >> 5, n4 = idx & 31;
        u32x2 w = {cvtpk(v[i][0], v[i][1]), cvtpk(v[i][2], v[i][3])};
        *(LAS u32x2*)(lds + k * RS + n4 * 8) = w; }
}
DI void tconv_tr(LAS unsigned char* lds, LAS unsigned char* img2) {
    int tid = threadIdx.x; asm volatile("" : "+v"(tid)); const int lane = tid & 63; constexpr int RS = 264;
    const int n = tid & 127, kq = tid >> 7;
    const unsigned ad = (unsigned)(uintptr_t)lds + (unsigned)((kq * 32 + ((lane >> 2) & 3)) * RS + (n & ~15) * 2 + 8 * (lane & 3));
    s16x4 lo[4], hi[4];
#define TCRD(dst, off) asm volatile("ds_read_b64_tr_b16 %0, %1 offset:%2" : "=&v"(dst) : "v"(ad), "i"(off) : "memory")
    TCRD(lo[0], 0 * RS); TCRD(hi[0], 4 * RS); TCRD(lo[1], 8 * RS); TCRD(hi[1], 12 * RS); TCRD(lo[2], 16 * RS); TCRD(hi[2], 20 * RS); TCRD(lo[3], 24 * RS); TCRD(hi[3], 28 * RS);
#undef TCRD
    asm volatile("s_waitcnt lgkmcnt(0)" ::: "memory");
#pragma unroll
    for (int j = 0; j < 4; ++j) { const bf16x8 w = __builtin_shufflevector(lo[j], hi[j], 0, 1, 2, 3, 4, 5, 6, 7);
        *(LAS bf16x8*)(img2 + n * 272 + (kq * 32 + j * 8) * 2) = w; }
}
DI void tconv_store(const TcJob& J, const LAS unsigned char* img2) {
    int tid = threadIdx.x; asm volatile("" : "+v"(tid));
#pragma unroll
    for (int i = 0; i < 4; ++i) { const int p = tid + 512 * i, n = p >> 4, k8 = p & 15;
        const u32x4 w = *(const LAS u32x4*)(img2 + n * 272 + k8 * 16);
        if (J.f8 != 0.f) *(u32x2*)((unsigned char*)J.dst + (size_t)n * J.K + J.k0 + k8 * 8) = cvt8_fp8(w, J.f8);
        else *(u32x4*)(J.dst + (size_t)n * J.K + J.k0 + k8 * 8) = w; }
}
DI void norm_row(const float* xrow, const float* g, bf16_t* hrow, int lane) {
    f32x4 v[8]; float ss = 0.f;
#pragma unroll
    for (int i = 0; i < 8; ++i) { v[i] = *(const f32x4*)(xrow + i * 256 + lane * 4); ss += (v[i][0] * v[i][0] + v[i][1] * v[i][1]) + (v[i][2] * v[i][2] + v[i][3] * v[i][3]); }
    ss = wave_sum(ss);
    const float rs = __builtin_amdgcn_rsqf(ss * (1.0f / 2048.0f) + 1e-6f);
#pragma unroll
    for (int i = 0; i < 8; ++i) { const f32x4 gg = *(const f32x4*)(g + i * 256 + lane * 4);
        u32x2 w = {cvtpk(v[i][0] * rs * gg[0], v[i][1] * rs * gg[1]), cvtpk(v[i][2] * rs * gg[2], v[i][3] * rs * gg[3])};
        *(u32x2*)(hrow + i * 256 + lane * 4) = w; }
}

template <bool B16> DI void norm_rows4(const void* xv, const bf16_t* z, const float* g, bf16_t* h, int row0, int lane, unsigned char* h8 = nullptr, LAS unsigned char* hl = nullptr, bool to_lds = false) {
    f32x4 v[4][8]; float ss[4];
#pragma unroll
    for (int r = 0; r < 4; ++r)
#pragma unroll
        for (int i = 0; i < 8; ++i) {
            if (B16) { const u32x2 xx = *(const u32x2*)((const bf16_t*)xv + (size_t)(row0 + r) * DM + i * 256 + lane * 4); v[r][i] = (f32x4){bflo(xx[0]), bfhi(xx[0]), bflo(xx[1]), bfhi(xx[1])}; }
            else v[r][i] = *(const f32x4*)((const float*)xv + (size_t)(row0 + r) * DM + i * 256 + lane * 4); }
    if (z) {
#pragma unroll
        for (int r = 0; r < 4; ++r)
#pragma unroll
            for (int i = 0; i < 8; ++i) { const u32x2 zz = *(const u32x2*)(z + (size_t)(row0 + r) * DM + i * 256 + lane * 4);
                v[r][i][0] += bflo(zz[0]); v[r][i][1] += bfhi(zz[0]); v[r][i][2] += bflo(zz[1]); v[r][i][3] += bfhi(zz[1]); } }
#pragma unroll
    for (int r = 0; r < 4; ++r) { float s = 0.f;
#pragma unroll
        for (int i = 0; i < 8; ++i) s += (v[r][i][0] * v[r][i][0] + v[r][i][1] * v[r][i][1]) + (v[r][i][2] * v[r][i][2] + v[r][i][3] * v[r][i][3]);
        ss[r] = s; }
#pragma unroll
    for (int o = 32; o >= 1; o >>= 1) {
#pragma unroll
        for (int r = 0; r < 4; ++r) ss[r] += __shfl_xor(ss[r], o); }
#pragma unroll
    for (int i = 0; i < 8; ++i) { const f32x4 gg = *(const f32x4*)(g + i * 256 + lane * 4);
#pragma unroll
        for (int r = 0; r < 4; ++r) { const float rs = __builtin_amdgcn_rsqf(ss[r] * (1.0f / 2048.0f) + 1e-6f);
            const float h0 = v[r][i][0] * rs * gg[0], h1 = v[r][i][1] * rs * gg[1], h2 = v[r][i][2] * rs * gg[2], h3 = v[r][i][3] * rs * gg[3];
            u32x2 w = {cvtpk(h0, h1), cvtpk(h2, h3)};
            if (to_lds) *(LAS u32x2*)(hl + r * 4112 + (i * 256 + lane * 4) * 2) = w; else *(u32x2*)(h + (size_t)(row0 + r) * DM + i * 256 + lane * 4) = w;
            if (h8) *(unsigned*)(h8 + (size_t)(row0 + r) * DM + i * 256 + lane * 4) = cvt4_fp8(h0, h1, h2, h3, 8.f); } }
}

struct Args { const float* in[18]; float* out; unsigned char* ws; int ph_lo, ph_hi; };

template <int SET> DI void conv_jobs(const Args& a, LAS unsigned char* lds) {
    const int G = gridDim.x, bx = blockIdx.x;
    typedef __attribute__((address_space(4))) const unsigned long long KArg;
#define KIN(k) ((const float*)((KArg*)__builtin_amdgcn_kernarg_segment_ptr())[k])
    unsigned char* ws = (unsigned char*)((KArg*)__builtin_amdgcn_kernarg_segment_ptr())[19];
    constexpr int J0 = 672, J1 = J0 + 256, J2 = J1 + 768, J3 = J2 + 256, J4 = J3 + 4096, J5 = J4 + 4096, J6 = J5 + 4096, J7 = J6 + 64, J8 = J7 + 2;
#define TC_DECODE(J, job) do { int kt_; J.f8 = 0.f; \
        if (job < J0) { const int i = job; kt_ = i % 16; J.n0 = (i / 16) * 128; J.src = KIN(3); J.ld = 5168; J.nvalid = 5168; J.K = 2048; J.dst = (bf16_t*)(ws + WS_WIN0) + (size_t)J.n0 * 2048; } \
        else if (job < J1) { const int i = job - J0; kt_ = i % 16; J.n0 = (i / 16) * 128; J.src = KIN(8); J.ld = 2048; J.nvalid = 2048; J.K = 2048; J.dst = (bf16_t*)(ws + WS_WOUT0) + (size_t)J.n0 * 2048; } \
        else if (job < J2) { const int i = job - J1; kt_ = i % 16; J.n0 = (i / 16) * 128; J.src = KIN(9); J.ld = 6144; J.nvalid = 6144; J.K = 2048; J.dst = (bf16_t*)(ws + WS_WIN1 + (size_t)J.n0 * 2048); J.f8 = 256.f; } \
        else if (job < J3) { const int i = job - J2; kt_ = i % 16; J.n0 = (i / 16) * 128; J.src = KIN(10); J.ld = 2048; J.nvalid = 2048; J.K = 2048; J.dst = (bf16_t*)(ws + WS_WOUT1 + (size_t)J.n0 * 2048); J.f8 = 256.f; } \
        else if (job < J5) { const bool up = job >= J4; const int i = job - (up ? J4 : J3); const int mat = i >> 6, r = i & 63; kt_ = r % 16; J.n0 = (r / 16) * 128; \
            J.src = (up ? KIN(16) : KIN(15)) + (size_t)mat * 2048 * 512; J.ld = 512; J.nvalid = 512; J.K = 2048; \
            J.dst = (bf16_t*)(ws + WS_W1 + ((size_t)mat * 1024 + (J.n0 / 128) * 256 + (up ? 128 : 0)) * 2048); J.f8 = 256.f; } \
        else if (job < J6) { const int i = job - J5; const int mat = i >> 6, r = i & 63; kt_ = r % 4; J.n0 = (r / 4) * 128; \
            J.src = KIN(17) + (size_t)mat * 512 * 2048; J.ld = 2048; J.nvalid = 2048; J.K = 512; J.dst = (bf16_t*)(ws + WS_W2 + ((size_t)mat * 2048 + J.n0) * 512); J.f8 = 128.f; } \
        else if (job < J7) { const int i = job - J6; const int kv = i >> 5; kt_ = i & 31; J.n0 = 0; J.src = KIN(6) + (size_t)kv * 4096 * 128; J.ld = 128; J.nvalid = 128; J.K = 4096; J.dst = (bf16_t*)(ws + WS_CW1) + (size_t)kv * 128 * 4096; } \
        else { const int kv = job - J7; kt_ = 0; J.n0 = 0; J.src = KIN(7) + (size_t)kv * 128 * 128; J.ld = 128; J.nvalid = 128; J.K = 128; J.dst = (bf16_t*)(ws + WS_CW2) + (size_t)kv * 128 * 128; } \
        J.k0 = kt_ * 128; } while (0)
    constexpr int NQ = SET == 0 ? 928 + 66 : SET == 1 ? 1024 + 3 * 2048 : 3 * 2048;
#define TC_MAP(q) (SET == 0 ? ((q) < 928 ? (q) : 14240 + ((q) - 928)) : SET == 1 ? ((q) < 1024 ? 928 + (q) : (((q) - 1024) >> 11) * 4096 + 1952 + (((q) - 1024) & 2047)) : ((q) >> 11) * 4096 + 4000 + ((q) & 2047))
    {
        int q = bx; f32x4 va[8], vb[8];
        LAS unsigned char* img2 = lds + 128 * 264;
        __syncthreads();
        if (q < NQ) { TcJob J; const int job = TC_MAP(q); TC_DECODE(J, job); tconv_load(J, va); }
        if (q + G < NQ) { TcJob J; const int job = TC_MAP(q + G); TC_DECODE(J, job); tconv_load(J, vb); }
        while (q < NQ) {
            tconv_lds(va, lds);
            __syncthreads();
            if (q + 2 * G < NQ) { TcJob J; const int job = TC_MAP(q + 2 * G); TC_DECODE(J, job); tconv_load(J, va); }
            tconv_tr(lds, img2);
            __syncthreads();
            { TcJob J; const int job = TC_MAP(q); TC_DECODE(J, job); tconv_store(J, img2); }
            q += G; if (q >= NQ) break;
            tconv_lds(vb, lds);
            __syncthreads();
            if (q + 2 * G < NQ) { TcJob J; const int job = TC_MAP(q + 2 * G); TC_DECODE(J, job); tconv_load(J, vb); }
            tconv_tr(lds, img2);
            __syncthreads();
            { TcJob J; const int job = TC_MAP(q); TC_DECODE(J, job); tconv_store(J, img2); }
            q += G;
        }
        __syncthreads();
    }
#undef TC_DECODE
#undef TC_MAP
#undef KIN
}
DI void phase_prologue(const Args& a, LAS unsigned char* lds) {
    const int tid = threadIdx.x, wid = tid >> 6, lane = tid & 63, G = gridDim.x, bx = blockIdx.x;
    unsigned char* ws = a.ws;
    conv_jobs<0>(a, lds);
    for (int i = bx * 512 + tid; i < 2 * 48 * 2048; i += G * 512) { const int k = i & 2047, r = (i >> 11) % 48, L = (i >> 11) / 48;
        float v = 0.f; if (r < 4) v = a.in[11][((size_t)L * 2048 + k) * 4 + r]; else if (r < 36) v = a.in[13][((size_t)L * 2048 + k) * 32 + (r - 4)];
        ((bf16_t*)(ws + WS_WR))[i] = (bf16_t)(cvtpk(v, 0.f) & 0xffffu); }
    for (int o = bx; o < 256; o += G) if (wid == 0) { const int kv = o >> 7, f = o & 127; float s0 = 0.f, s1 = 0.f, s2 = 0.f, s3 = 0.f;
#pragma unroll 4
        for (int kk = lane; kk < 4096; kk += 256) { const float* pe = a.in[5] + kv * 4096 + kk; const float* w1 = a.in[6] + ((size_t)kv * 4096 + kk) * 128 + f;
            s0 += pe[0] * w1[0]; s1 += pe[64] * w1[64 * 128]; s2 += pe[128] * w1[128 * 128]; s3 += pe[192] * w1[192 * 128]; }
        const float s = wave_sum((s0 + s1) + (s2 + s3)); if (lane == 0) ((float*)(ws + WS_BIAS1))[o] = s; }
    for (int row0 = (bx * 8 + wid) * 4; row0 < NTOK; row0 += G * 32) norm_rows4<false>(a.in[0], nullptr, a.in[1], (bf16_t*)(ws + WS_H), row0, lane);
}

DI void phase_norm(const float* x, const float* g, bf16_t* h) {
    const int tid = threadIdx.x, wid = tid >> 6, lane = tid & 63;
    for (int row = blockIdx.x * 8 + wid; row < NTOK; row += gridDim.x * 8) norm_row(x + (size_t)row * DM, g, h + (size_t)row * DM, lane);
}

DI void cmp_item(LAS unsigned char* lds, int item, const bf16_t* proj, const bf16_t* cw1t, const bf16_t* cw2t, const float* bias1, const float* gain1, bf16_t* kcmp, bf16_t* vcmp) {
    const int tid = threadIdx.x, wid = __builtin_amdgcn_readfirstlane(tid >> 6), lane = tid & 63, fr = lane & 15, fq = lane >> 4, kq = wid & 3, nh = wid >> 2;
    const int kv = item >> 7, rt = item & 127, bg = rt >> 4, n0 = (rt & 15) * 32, b = bg >> 2, g = bg & 3;
    int na = n0 + fr, nb = n0 + 16 + fr; na = na < 510 ? na : 510; nb = nb < 510 ? nb : 510;
    const bf16_t* a0p = proj + ((size_t)b * T_ + 16 * na) * LDP0 + C_KC + kv * 512 + g * 128 + fq * 8;
    const bf16_t* a1p = proj + ((size_t)b * T_ + 16 * nb) * LDP0 + C_KC + kv * 512 + g * 128 + fq * 8;
    const bf16_t* bp = cw1t + (size_t)(kv * 128 + nh * 64 + fr) * 4096 + fq * 8;
    f32x4 acc[2][4];
#pragma unroll
    for (int rb = 0; rb < 2; ++rb)
#pragma unroll
        for (int ct = 0; ct < 4; ++ct) acc[rb][ct] = (f32x4){0.f, 0.f, 0.f, 0.f};
#pragma unroll 4
    for (int k2 = 0; k2 < 32; ++k2) { const int ks = kq * 32 + k2, l = ks >> 2, dp = (ks & 3) * 32;
        const bf16x8 a0 = *(const bf16x8*)(a0p + (size_t)l * LDP0 + dp), a1 = *(const bf16x8*)(a1p + (size_t)l * LDP0 + dp);
#pragma unroll
        for (int ct = 0; ct < 4; ++ct) { const bf16x8 bb = *(const bf16x8*)(bp + (size_t)ct * 16 * 4096 + ks * 32);
            acc[0][ct] = __builtin_amdgcn_mfma_f32_16x16x32_bf16(a0, bb, acc[0][ct], 0, 0, 0);
            acc[1][ct] = __builtin_amdgcn_mfma_f32_16x16x32_bf16(a1, bb, acc[1][ct], 0, 0, 0); } }
    constexpr int HP = 272;
    LAS float* red = (LAS float*)(lds + 16384);
    __syncthreads();
#pragma unroll
    for (int rb = 0; rb < 2; ++rb)
#pragma unroll
        for (int ct = 0; ct < 4; ++ct)
#pragma unroll
            for (int j = 0; j < 4; ++j) red[(kq * 32 + rb * 16 + fq * 4 + j) * 128 + nh * 64 + ct * 16 + fr] = acc[rb][ct][j];
    __syncthreads();
#pragma unroll
    for (int i = 0; i < 8; ++i) { const int idx = tid + 512 * i, row = idx >> 7, col = idx & 127;
        const float x = ((red[idx] + red[4096 + idx]) + (red[8192 + idx] + red[12288 + idx])) + bias1[kv * 128 + col];
        const float u = 0.7978845608028654f * (x + 0.044715f * x * x * x);
        const float hv = x * __builtin_amdgcn_rcpf(1.0f + __builtin_amdgcn_exp2f(-2.0f * LOG2E * u));
        *(LAS unsigned short*)(lds + row * HP + col * 2) = (unsigned short)(cvtpk(hv, 0.f) & 0xffffu); }
    __syncthreads();
    f32x4 ac2[2] = {{0.f, 0.f, 0.f, 0.f}, {0.f, 0.f, 0.f, 0.f}};
    const bf16_t* b2base = cw2t + (size_t)(kv * 128 + wid * 16 + fr) * 128 + fq * 8;
#pragma unroll
    for (int ks = 0; ks < 4; ++ks) { const bf16x8 bb = *(const bf16x8*)(b2base + ks * 32);
#pragma unroll
        for (int rb = 0; rb < 2; ++rb) { const bf16x8 aa = *(const LAS bf16x8*)(lds + (rb * 16 + fr) * HP + (ks * 32 + fq * 8) * 2);
            ac2[rb] = __builtin_amdgcn_mfma_f32_16x16x32_bf16(aa, bb, ac2[rb], 0, 0, 0); } }
    LAS float* part = (LAS float*)(lds + 32 * HP);
    float scl[2][4];
    if (kv == 0) {
#pragma unroll
        for (int rb = 0; rb < 2; ++rb)
#pragma unroll
            for (int j = 0; j < 4; ++j) { float s = ac2[rb][j] * ac2[rb][j]; s += __shfl_xor(s, 1); s += __shfl_xor(s, 2); s += __shfl_xor(s, 4); s += __shfl_xor(s, 8);
                if (fr == 0) part[wid * 32 + rb * 16 + fq * 4 + j] = s; }
        __syncthreads();
        const float gn = gain1[wid * 16 + fr];
#pragma unroll
        for (int rb = 0; rb < 2; ++rb)
#pragma unroll
            for (int j = 0; j < 4; ++j) { float s = 0.f;
#pragma unroll
                for (int w = 0; w < 8; ++w) s += part[w * 32 + rb * 16 + fq * 4 + j];
                scl[rb][j] = __builtin_amdgcn_rsqf(s * (1.0f / 128.0f) + 1e-6f) * gn; }
    } else {
#pragma unroll
        for (int rb = 0; rb < 2; ++rb)
#pragma unroll
            for (int j = 0; j < 4; ++j) scl[rb][j] = 1.0f;
    }
    bf16_t* dst = (kv == 0 ? kcmp : vcmp) + (size_t)(bg * 512 + n0) * 128 + wid * 16 + fr;
#pragma unroll
    for (int rb = 0; rb < 2; ++rb)
#pragma unroll
        for (int j = 0; j < 4; ++j) dst[(size_t)(rb * 16 + fq * 4 + j) * 128] = (bf16_t)(cvtpk(ac2[rb][j] * scl[rb][j], 0.f) & 0xffffu);
    __syncthreads();
}
DI void knorm_phase(bf16_t* proj, const float* qk_gain) {
    const int gid = blockIdx.x * 512 + threadIdx.x, sub = gid & 15, stride = gridDim.x * 32;
    for (int rowid0 = gid >> 4; rowid0 < NTOK * 8; rowid0 += 4 * stride) {
        u32x4 raw[4]; bf16_t* p[4]; int sw[4];
#pragma unroll
        for (int u = 0; u < 4; ++u) { int rowid = rowid0 + u * stride; rowid = rowid < NTOK * 8 ? rowid : NTOK * 8 - 1; const int tok = rowid >> 3, selw = (rowid >> 2) & 1, g = rowid & 3; sw[u] = selw;
            p[u] = proj + (size_t)tok * LDP0 + (selw ? C_KW : C_KS) + g * 128 + sub * 8; raw[u] = *(const u32x4*)p[u]; }
#pragma unroll
        for (int u = 0; u < 4; ++u) { float f[8]; float ss = 0.f;
#pragma unroll
            for (int e = 0; e < 4; ++e) { f[2 * e] = bflo(raw[u][e]); f[2 * e + 1] = bfhi(raw[u][e]); ss += f[2 * e] * f[2 * e] + f[2 * e + 1] * f[2 * e + 1]; }
            ss += __shfl_xor(ss, 1); ss += __shfl_xor(ss, 2); ss += __shfl_xor(ss, 4); ss += __shfl_xor(ss, 8);
            const float rs = __builtin_amdgcn_rsqf(ss * (1.0f / 128.0f) + 1e-6f);
            const float* gp = qk_gain + (sw[u] ? 3 : 2) * 128 + sub * 8; const f32x4 g0 = *(const f32x4*)gp, g1 = *(const f32x4*)(gp + 4);
            u32x4 w = {cvtpk(f[0] * rs * g0[0], f[1] * rs * g0[1]), cvtpk(f[2] * rs * g0[2], f[3] * rs * g0[3]), cvtpk(f[4] * rs * g1[0], f[5] * rs * g1[1]), cvtpk(f[6] * rs * g1[2], f[7] * rs * g1[3])};
            if (rowid0 + u * stride < NTOK * 8) *(u32x4*)p[u] = w; }
    }
}
DI void mini_gemm48(LAS unsigned char* lds, const bf16_t* A, const bf16_t* Wt) {
    const int tid = threadIdx.x, wid = __builtin_amdgcn_readfirstlane(tid >> 6), lane = tid & 63, fr = lane & 15, fq = lane >> 4, rb = wid & 3, kh = wid >> 2;
    const bf16_t* ap = A + (size_t)(rb * 16 + fr) * DM + kh * 1024 + fq * 8;
    const bf16_t* bp = Wt + (size_t)fr * DM + kh * 1024 + fq * 8;
    f32x4 acc[3] = {{0.f, 0.f, 0.f, 0.f}, {0.f, 0.f, 0.f, 0.f}, {0.f, 0.f, 0.f, 0.f}};
#pragma unroll 8
    for (int ks = 0; ks < 32; ++ks) { const bf16x8 a = *(const bf16x8*)(ap + ks * 32);
#pragma unroll
        for (int ct = 0; ct < 3; ++ct) { const bf16x8 bb = *(const bf16x8*)(bp + (size_t)ct * 16 * DM + ks * 32); acc[ct] = __builtin_amdgcn_mfma_f32_16x16x32_bf16(a, bb, acc[ct], 0, 0, 0); } }
    LAS float* part = (LAS float*)lds;
    __syncthreads();
#pragma unroll
    for (int ct = 0; ct < 3; ++ct)
#pragma unroll
        for (int j = 0; j < 4; ++j) part[(kh * 64 + rb * 16 + fq * 4 + j) * 48 + ct * 16 + fr] = acc[ct][j];
    __syncthreads();
    LAS float* out = (LAS float*)(lds + 24576);
    for (int i = tid; i < 64 * 48; i += 512) out[i] = part[i] + part[64 * 48 + i];
    __syncthreads();
}
DI void mini_gemm32_lds(LAS unsigned char* lds, const bf16_t* Wt, LAS float* out) {
    int tid = threadIdx.x; asm volatile("" : "+v"(tid)); const int wid = __builtin_amdgcn_readfirstlane(tid >> 6), lane = tid & 63, fr = lane & 15, fq = lane >> 4, rb = wid & 1, kq = wid >> 1;
    const LAS unsigned char* ap = lds + (rb * 16 + fr) * 4112 + (kq * 512 + fq * 8) * 2;
    const bf16_t* bp = Wt + (size_t)fr * DM + kq * 512 + fq * 8;
    f32x4 acc[3] = {{0.f, 0.f, 0.f, 0.f}, {0.f, 0.f, 0.f, 0.f}, {0.f, 0.f, 0.f, 0.f}};
#pragma unroll 8
    for (int ks = 0; ks < 16; ++ks) { const bf16x8 a = *(const LAS bf16x8*)(ap + ks * 64);
#pragma unroll
        for (int ct = 0; ct < 3; ++ct) { const bf16x8 bb = *(const bf16x8*)(bp + (size_t)ct * 16 * DM + ks * 32); acc[ct] = __builtin_amdgcn_mfma_f32_16x16x32_bf16(a, bb, acc[ct], 0, 0, 0); } }
    LAS float* part = (LAS float*)lds;
    __syncthreads();
#pragma unroll
    for (int ct = 0; ct < 3; ++ct)
#pragma unroll
        for (int j = 0; j < 4; ++j) part[(kq * 32 + rb * 16 + fq * 4 + j) * 48 + ct * 16 + fr] = acc[ct][j];
    __syncthreads();
    for (int i = tid; i < 32 * 48; i += 512) out[i] = (part[i] + part[1536 + i]) + (part[3072 + i] + part[4608 + i]);
    __syncthreads();
}
DI void gates_phase(LAS unsigned char* lds, const bf16_t* H, const bf16_t* Wt, float* gates) {
    int tid = threadIdx.x; asm volatile("" : "+v"(tid)); const int wid = tid >> 6, lane = tid & 63;
    __syncthreads();
    for (int chunk = blockIdx.x; chunk < NTOK / 64; chunk += gridDim.x) {
#pragma unroll 1
        for (int b = 0; b < 2; ++b) {
            u32x4 t[4][4];
#pragma unroll
            for (int r = 0; r < 4; ++r)
#pragma unroll
                for (int q = 0; q < 4; ++q) t[r][q] = *(const u32x4*)(H + (size_t)(chunk * 64 + b * 32 + wid * 4 + r) * DM + (q * 64 + lane) * 8);
#pragma unroll
            for (int r = 0; r < 4; ++r)
#pragma unroll
                for (int q = 0; q < 4; ++q) *(LAS u32x4*)(lds + (wid * 4 + r) * 4112 + (q * 64 + lane) * 16) = t[r][q];
            __syncthreads();
            mini_gemm32_lds(lds, Wt, (LAS float*)(lds + 131584) + b * 32 * 48);
        }
        const LAS float* out = (const LAS float*)(lds + 131584);
        for (int i = tid; i < 64 * 48; i += 512) gates[(size_t)chunk * 64 * 48 + i] = __builtin_amdgcn_rcpf(1.0f + __builtin_amdgcn_exp2f(-out[i] * LOG2E));
        __syncthreads();
    }
}
template <bool B16> DI void norm_route_phase(LAS unsigned char* lds, const void* x, const bf16_t* z, const float* g, bf16_t* H, unsigned char* H8, const bf16_t* Wt, const float* bgp, const float* brp, unsigned* cnt, int* rows, float* tokinfo) {
    int tid = threadIdx.x; asm volatile("" : "+v"(tid)); const int wid = tid >> 6, lane = tid & 63;
    LAS unsigned* hist = (LAS unsigned*)(lds + 143872); LAS unsigned* base = hist + 32;
    for (int chunk = blockIdx.x; chunk < NTOK / 64; chunk += gridDim.x) {
#pragma unroll 1
        for (int b = 0; b < 2; ++b) {
            norm_rows4<B16>(x, z, g, H, chunk * 64 + b * 32 + wid * 4, lane, H8, lds + wid * 4 * 4112, true);
            __syncthreads();
            mini_gemm32_lds(lds, Wt, (LAS float*)(lds + 131584) + b * 32 * 48);
        }
        if (tid < 32) hist[tid] = 0u;
        __syncthreads();
        const LAS float* out = (const LAS float*)(lds + 131584);
        int e1 = 0, e2 = 0; float w1 = 0.f, w2 = 0.f; unsigned p1 = 0, p2 = 0; const int tok = chunk * 64 + tid;
        if (tid < 64) {
            const LAS float* lg = out + tid * 48;
            float gl[4]; float gm = -3.0e38f; int gs = 0;
#pragma unroll
            for (int i = 0; i < 4; ++i) { gl[i] = lg[i] + bgp[i]; if (gl[i] > gm) { gm = gl[i]; gs = i; } }
            float gsum = 0.f;
#pragma unroll
            for (int i = 0; i < 4; ++i) gsum += __expf(gl[i] - gm);
            const float pg = 1.0f / gsum;
            float el[8]; float m1 = -3.0e38f; int s1 = 0;
#pragma unroll
            for (int i = 0; i < 8; ++i) { el[i] = lg[4 + gs * 8 + i] + brp[gs * 8 + i]; if (el[i] > m1) { m1 = el[i]; s1 = i; } }
            float m2 = -3.0e38f; int s2 = 0;
#pragma unroll
            for (int i = 0; i < 8; ++i) if (i != s1 && el[i] > m2) { m2 = el[i]; s2 = i; }
            const float x2 = __expf(m2 - m1), den = 1.0f / (1.0f + x2);
            w1 = pg * den; w2 = pg * x2 * den; e1 = gs * 8 + s1; e2 = gs * 8 + s2;
            p1 = __hip_atomic_fetch_add(hist + e1, 1u, __ATOMIC_RELAXED, __HIP_MEMORY_SCOPE_WORKGROUP);
            p2 = __hip_atomic_fetch_add(hist + e2, 1u, __ATOMIC_RELAXED, __HIP_MEMORY_SCOPE_WORKGROUP);
        }
        __syncthreads();
        if (tid < 32) { const unsigned hcount = hist[tid]; base[tid] = hcount ? __hip_atomic_fetch_add(cnt + tid, hcount, __ATOMIC_RELAXED, __HIP_MEMORY_SCOPE_AGENT) : 0u; }
        __syncthreads();
        if (tid < 64) { p1 += base[e1]; p2 += base[e2];
            rows[e1 * 16384 + (int)p1] = tok; rows[e2 * 16384 + (int)p2] = tok;
            float* ti = tokinfo + (size_t)tok * 8; ti[0] = __int_as_float(e1); ti[1] = __int_as_float((int)p1); ti[2] = w1; ti[3] = __int_as_float(e2); ti[4] = __int_as_float((int)p2); ti[5] = w2; }
        __syncthreads();
    }
}
DI int moe_tables(LAS unsigned char* misc, const unsigned* cnt) {
    int tid = threadIdx.x; asm volatile("" : "+v"(tid)); LAS int* w = (LAS int*)misc;
    __syncthreads();
    if (tid < 32) w[16 + tid] = (int)cnt[tid];
    __syncthreads();
    if (tid == 0) { int acc = 0; for (int e = 0; e < 32; ++e) { w[48 + e] = acc; acc += (w[16 + e] + 255) >> 8; } w[80] = acc; }
    __syncthreads();
    const int ntot = w[80];
    for (int rt = tid; rt < ntot; rt += 512) { int e = 0;
        for (int k = 0; k < 32; ++k) if (w[48 + k] <= rt && rt < w[48 + k + 1]) e = k;
        const int loc = (rt - w[48 + e]) * 256; int nv = w[16 + e] - loc; nv = nv > 256 ? 256 : nv;
        w[128 + rt * 4] = e; w[128 + rt * 4 + 1] = e * 16384 + loc; w[128 + rt * 4 + 2] = nv; w[128 + rt * 4 + 3] = 0; }
    __syncthreads();
    return ntot;
}
template <bool B16> DI void combine_phase(LAS unsigned char* misc, const float* tokinfo, const bf16_t* Y, const void* xbase, const bf16_t* z, bf16_t* xr, float* out, const float* gnext, bf16_t* h) {
    const int tid = threadIdx.x, wid = tid >> 6, lane = tid & 63; const LAS int* w = (const LAS int*)misc;
    for (int tok = blockIdx.x * 8 + wid; tok < NTOK; tok += gridDim.x * 8) {
        const float* ti = tokinfo + (size_t)tok * 8;
        const int e1 = __float_as_int(ti[0]), p1 = __float_as_int(ti[1]), e2 = __float_as_int(ti[3]), p2 = __float_as_int(ti[4]); const float w1 = ti[2], w2 = ti[5];
        const unsigned char* y1 = (const unsigned char*)Y + ((size_t)w[48 + e1] * 256 + p1) * DM; const unsigned char* y2 = (const unsigned char*)Y + ((size_t)w[48 + e2] * 256 + p2) * DM;
        const float w1s = w1 * 0.0625f, w2s = w2 * 0.0625f;
        const bf16_t* zp = z + (size_t)tok * DM; bf16_t* xp = xr + (size_t)tok * DM; f32x4 v[8]; float ss = 0.f;
#pragma unroll
        for (int i = 0; i < 8; ++i) { const int col = i * 256 + lane * 4; f32x4 x; if (B16) { const u32x2 xx = *(const u32x2*)((const bf16_t*)xbase + (size_t)tok * DM + col); x = (f32x4){bflo(xx[0]), bfhi(xx[0]), bflo(xx[1]), bfhi(xx[1])}; } else x = *(const f32x4*)((const float*)xbase + (size_t)tok * DM + col);
            const u32x2 zz = *(const u32x2*)(zp + col); x[0] += bflo(zz[0]); x[1] += bfhi(zz[0]); x[2] += bflo(zz[1]); x[3] += bfhi(zz[1]);
            const int a = *(const int*)(y1 + col), bq = *(const int*)(y2 + col);
            const f32x2 a01 = __builtin_amdgcn_cvt_pk_f32_fp8(a, false), a23 = __builtin_amdgcn_cvt_pk_f32_fp8(a, true), b01 = __builtin_amdgcn_cvt_pk_f32_fp8(bq, false), b23 = __builtin_amdgcn_cvt_pk_f32_fp8(bq, true);
            v[i][0] = x[0] + (w1s * a01[0] + w2s * b01[0]); v[i][1] = x[1] + (w1s * a01[1] + w2s * b01[1]);
            v[i][2] = x[2] + (w1s * a23[0] + w2s * b23[0]); v[i][3] = x[3] + (w1s * a23[1] + w2s * b23[1]);
            ss += (v[i][0] * v[i][0] + v[i][1] * v[i][1]) + (v[i][2] * v[i][2] + v[i][3] * v[i][3]); }
        if (out) {
#pragma unroll
            for (int i = 0; i < 8; ++i) *(f32x4*)(out + (size_t)tok * DM + i * 256 + lane * 4) = v[i];
        } else {
            ss = wave_sum(ss); const float rs = __builtin_amdgcn_rsqf(ss * (1.0f / 2048.0f) + 1e-6f);
#pragma unroll
            for (int i = 0; i < 8; ++i) { const int col = i * 256 + lane * 4; { u32x2 xw = {cvtpk(v[i][0], v[i][1]), cvtpk(v[i][2], v[i][3])}; *(u32x2*)(xp + col) = xw; } const f32x4 gg = *(const f32x4*)(gnext + col);
                *(unsigned*)((unsigned char*)h + (size_t)tok * DM + col) = cvt4_fp8(v[i][0] * rs * gg[0], v[i][1] * rs * gg[1], v[i][2] * rs * gg[2], v[i][3] * rs * gg[3], 8.f); }
        }
    }
}

#ifndef PROBE
#define PROBE 0
#endif
constexpr int NPHASE = 16;
__global__ void __launch_bounds__(512, 2) fwd(Args a) {
    extern __shared__ __attribute__((aligned(16))) unsigned char shm[];
    LAS unsigned char* lds = (LAS unsigned char*)shm;
    LAS unsigned char* misc = lds + LDS_MISC;
    const int tid = threadIdx.x, G = gridDim.x, bx = blockIdx.x;
    unsigned char* ws = a.ws;
    if (tid < 4) ((LAS unsigned*)misc)[tid] = 0u;
    __syncthreads();
    const int lo = a.ph_lo, hi = a.ph_hi;
    XcdBarrier bar; bar.bar = (unsigned*)(ws + WS_BAR); bar.x = 0; bar.st = nullptr;
    if (hi - lo > 1) bar = xcd_barrier_post((unsigned*)(ws + WS_BAR), (volatile LAS unsigned*)misc);
#ifndef PHMASK
#define PHMASK 0xFFFFu
#endif
#define IN(k) (((PHMASK >> (k)) & 1u) && lo <= (k) && (k) < hi)
#ifndef DBLMASK
#define DBLMASK 0u
#endif
#define REP(k) for (int rep_ = 0; rep_ < ((((DBLMASK) >> (k)) & 1u) ? 2 : 1); ++rep_)
#ifndef PROBE_T
#define PROBE_T -1
#endif
#define PT_SET(i) do { if (tid == 0) *(volatile LAS unsigned long long*)(misc + 16 + 8 * (i)) = __builtin_amdgcn_s_memrealtime(); } while (0)
#define SEAM(k) do { if (IN(k) && IN((k) + 1)) xcd_barrier(bar); if ((k) == PROBE_T) PT_SET(1); if ((k) + 1 == PROBE_T) PT_SET(0); } while (0)
    bf16_t* H = (bf16_t*)(ws + WS_H); bf16_t* PROJ = (bf16_t*)(ws + WS_PROJ); bf16_t* ATT = (bf16_t*)(ws + WS_ATT); bf16_t* XR = (bf16_t*)(ws + WS_XR);
    bf16_t* KCMP = (bf16_t*)(ws + WS_KCMP); bf16_t* VCMP = (bf16_t*)(ws + WS_VCMP);
    bf16_t* Y = (bf16_t*)(ws + WS_PROJ); bf16_t* ACT = (bf16_t*)(ws + WS_ATT);
#define H8 (ws + WS_W1 + (size_t)2 * 32 * 1024 * DM)
    int* ROWS = (int*)(ws + WS_ROWS); float* TOK = (float*)(ws + WS_TOK);

    float* GATES = (float*)(ws + WS_GATES);
    if (PROBE_T == 0) PT_SET(0);
    if (IN(0)) { phase_prologue(a, lds); } SEAM(0);
    if (IN(1)) { pg8::Gemm g{H, (const bf16_t*)(ws + WS_WIN0), DM}; pg8::StaticOrder S; S.init(NTOK, 5120, G, bx); pg8::EpiBf16 E{PROJ, LDP0};
        pg8::gemm_phase(lds, g, S, E); } SEAM(1);
    if (IN(2)) { for (int it = bx; it < 256; it += G) cmp_item(lds, it, PROJ, (const bf16_t*)(ws + WS_CW1), (const bf16_t*)(ws + WS_CW2), (const float*)(ws + WS_BIAS1), a.in[4] + 128, KCMP, VCMP);
        knorm_phase(PROJ, a.in[4]);
        gates_phase(lds, H, (const bf16_t*)(ws + WS_WIN0) + (size_t)5120 * DM, GATES);
#if PROBE & 1
        for (int it = bx; it < 256; it += G) cmp_item(lds, it, PROJ, (const bf16_t*)(ws + WS_CW1), (const bf16_t*)(ws + WS_CW2), (const float*)(ws + WS_BIAS1), a.in[4] + 128, KCMP, VCMP);
        gates_phase(lds, H, (const bf16_t*)(ws + WS_WIN0) + (size_t)5120 * DM, GATES);
#endif
        } SEAM(2);
#if PROBE & 2
    if (IN(2) && IN(3)) { for (int k = 0; k < 10; ++k) xcd_barrier(bar); }
#endif
    if (IN(3)) REP(3) {
#define NSA_ITEM(u) (((((u) & 255) & 7) << 7) | (((u) >> 8) == 0 ? (((u) & 255) >> 3) : ((u) >> 8) == 1 ? 63 - (((u) & 255) >> 3) : ((u) >> 8) == 2 ? 64 + (((u) & 255) >> 3) : 127 - (((u) & 255) >> 3)))
        if (bx & 1) conv_jobs<1>(a, lds);
        for (int u = bx; u < 1024; u += G) at::nsa_item((LAS char*)lds, G == 256 ? NSA_ITEM(u) : u, PROJ, KCMP, VCMP, GATES, a.in[4], ATT);
        if (!(bx & 1)) conv_jobs<1>(a, lds);
#undef NSA_ITEM
    } SEAM(3);
    bf16_t* Z = (bf16_t*)(ws + WS_Z);
    if (IN(4)) { pg8::Gemm g{ATT, (const bf16_t*)(ws + WS_WOUT0), DM}; pg8::StaticOrder S; S.init(NTOK, DM, G, bx); pg8::EpiBf16 E{Z, DM};
        pg8::gemm_phase(lds, g, S, E); } SEAM(4);
#define MOE_LAYER(L, p0) do { \
        unsigned* cnt = (unsigned*)(ws + WS_CNT) + 32 * (L); \
        if (IN((p0))) { if ((L) == 0) norm_route_phase<false>(lds, a.in[0], Z, a.in[2] + (L) * DM, H, H8, (const bf16_t*)(ws + WS_WR) + (size_t)(L) * 48 * DM, a.in[12] + (L) * 4, a.in[14] + (L) * 32, cnt, ROWS, TOK); \
            else norm_route_phase<true>(lds, XR, Z, a.in[2] + (L) * DM, H, H8, (const bf16_t*)(ws + WS_WR) + (size_t)(L) * 48 * DM, a.in[12] + (L) * 4, a.in[14] + (L) * 32, cnt, ROWS, TOK); } SEAM((p0)); \
        if (IN((p0) + 1)) { const int ntot = moe_tables(misc, cnt); \
            pg8::Gemm g{(const bf16_t*)H8, (const bf16_t*)(ws + WS_W1 + (size_t)(L) * 32 * 1024 * DM), DM / 2, 0x7c7c7c7c, 0x77777777}; \
            pg8::MoeOrder<true> S{ntot * 4, 4, G, bx, (const LAS int*)misc + 128, ROWS, (unsigned*)(ws + WS_FLAG) + (L) * 160 * 16, 0, 0}; pg8::EpiSwiglu8 E{(unsigned char*)ACT}; \
            pg8::gemm_phase<true>(lds, g, S, E); \
              \
            pg8::Gemm g2{ACT, (const bf16_t*)(ws + WS_W2 + (size_t)(L) * 32 * DM * 512), DEXP / 2, 0x7c7c7c7c, 0x78787878}; \
            const int rem1_ = (ntot * 4) % G, qh_ = (2 * ntot + 31) / 32 - 2 * ((ntot * 4) / G + 1); \
            pg8::MoeOrder<false> S2{ntot * 8, 8, G, G == 256 ? bx : (bx + (G >> 1)) % G, (const LAS int*)misc + 128, ROWS, (unsigned*)(ws + WS_FLAG) + (L) * 160 * 16, rem1_, qh_ < 0 ? 0 : qh_}; pg8::EpiF8 E2{(unsigned char*)Y, DM, 16.f}; \
            pg8::gemm_phase<true>(lds, g2, S2, E2); } SEAM((p0) + 2); \
        if (IN((p0) + 3)) { (void)moe_tables(misc, cnt); \
            if ((L) == 0) combine_phase<false>(misc, TOK, Y, a.in[0], Z, XR, nullptr, a.in[1] + DM, H); else combine_phase<true>(misc, TOK, Y, XR, Z, XR, a.out, a.in[1] + DM, H); \
            } SEAM((p0) + 3); } while (0)
    MOE_LAYER(0, 5);
    if (IN(9)) { pg8::Gemm g{H, (const bf16_t*)(ws + WS_WIN1), DM / 2, 0x7c7c7c7c, 0x77777777}; pg8::StaticOrder S; S.init(NTOK, LDP1, G, bx); pg8::EpiBf16 E{PROJ, LDP1};
        pg8::gemm_phase<true>(lds, g, S, E); } SEAM(9);
    if (IN(10)) REP(10) { if (bx & 1) conv_jobs<2>(a, lds);
        for (int u = bx; u < 1024; u += G) at::sb_item((LAS char*)lds, G == 256 ? (((((u & 255) & 7) + 8 * ((u >> 8) & 1)) << 6) | (((u >> 9) & 1) << 5) | ((u & 255) >> 3)) : u, PROJ, ATT);
        if (!(bx & 1)) conv_jobs<2>(a, lds); } SEAM(10);
    if (IN(11)) { pg8::Gemm g{ATT, (const bf16_t*)(ws + WS_WOUT1), DM / 2, 0x7b7b7b7b, 0x77777777}; pg8::StaticOrder S; S.init(NTOK, DM, G, bx); pg8::EpiBf16 E{Z, DM};
        pg8::gemm_phase<true>(lds, g, S, E); } SEAM(11);
    MOE_LAYER(1, 12);
#undef MOE_LAYER
    if (PROBE_T >= 0 && bx == 0 && tid == 0) { if (PROBE_T == NPHASE - 1) PT_SET(1);
        const unsigned long long d_ = (*(volatile LAS unsigned long long*)(misc + 24) - *(volatile LAS unsigned long long*)(misc + 16)) * 9ull, s_ = __builtin_amdgcn_s_memrealtime();
        while (__builtin_amdgcn_s_memrealtime() - s_ < d_) __builtin_amdgcn_s_sleep(8); }
#undef IN
#undef SEAM
}

extern "C" void kernel_launch(void* const* d_in, const int* in_sizes, int n_in, void* d_out, int out_size, void* d_ws, size_t ws_size, hipStream_t stream) {
    static int grid = 0;
    if (grid == 0) {
        if (n_in != 18 || out_size != NTOK * DM || ws_size < WS_END) { fprintf(stderr, "kernel_launch: unexpected shapes (n_in %d out %d ws %zu need %zu)\n", n_in, out_size, ws_size, (size_t)WS_END); grid = -1; return; }
        int dev = 0, cus = 0, per_cu = 0;
        if (hipGetDevice(&dev) != hipSuccess || hipDeviceGetAttribute(&cus, hipDeviceAttributeMultiprocessorCount, dev) != hipSuccess) { grid = -1; return; }
        if (hipFuncSetAttribute((const void*)fwd, hipFuncAttributeMaxDynamicSharedMemorySize, LDS_BYTES) != hipSuccess) { fprintf(stderr, "kernel_launch: hipFuncSetAttribute failed\n"); grid = -1; return; }
        if (hipOccupancyMaxActiveBlocksPerMultiprocessor(&per_cu, (const void*)fwd, 512, LDS_BYTES) != hipSuccess || per_cu < 1) { fprintf(stderr, "kernel_launch: occupancy query says %d\n", per_cu); }
        (void)hipGetLastError();
        grid = cus;
    }
    if (grid < 0) return;
    (void)hipMemsetAsync((char*)d_ws, 0, WS_ZERO_BYTES, stream);
    Args a{};
    for (int i = 0; i < 18; ++i) a.in[i] = (const float*)d_in[i];
    a.out = (float*)d_out; a.ws = (unsigned char*)d_ws;
#ifndef ONE_LAUNCH
#define ONE_LAUNCH 1
#endif
    if (ONE_LAUNCH) { a.ph_lo = 0; a.ph_hi = NPHASE; hipLaunchKernelGGL(fwd, dim3(grid), dim3(512), LDS_BYTES, stream, a); }
    else for (int p = 0; p < NPHASE; ++p) { a.ph_lo = p; a.ph_hi = p + 1; hipLaunchKernelGGL(fwd, dim3(grid), dim3(512), LDS_BYTES, stream, a); }
}
```
